# Optimizing an MI355X kernel written in HIP

```python
import jax
import jax.numpy as jnp
from jax import lax
import numpy as np

D_MODEL = 1024
BATCH = 8
SEQ = 4096
DEPTH = 2

GRID_W = 64
CTX_LEN = 256
EPS = 1e-6
NEG_INF = -1e30
N_MOD = 6

MLA_HEADS = 8
MLA_Q_LORA = 384
MLA_KV_LORA = 256
MLA_NOPE = 64
MLA_ROPE = 32
MLA_V = 64
MLA_QK = MLA_NOPE + MLA_ROPE
MLA_WIDTH = MLA_HEADS * MLA_V
ROPE_BASE = 10000.0
Q_BLOCK = 128

NA_HEADS = 4
NA_HEAD_DIM = 64
NA_WIDTH = NA_HEADS * NA_HEAD_DIM
NA_WIN_ROWS = 8
NA_WIN_COLS = 16
NA_COL_BLOCK = 16
NA_COL_SPAN = NA_COL_BLOCK + NA_WIN_COLS

CM_GROUPS = 4
CM_CHUNK = 128
CM_WIDTH = 256
CM_GROUP_DIM = CM_WIDTH // CM_GROUPS

N_BRANCH = 3
MIX_WIDTH = MLA_WIDTH + NA_WIDTH + CM_WIDTH
IN_SPLITS = (MLA_Q_LORA, MLA_KV_LORA, MLA_ROPE, NA_WIDTH, NA_WIDTH, NA_WIDTH, CM_WIDTH, CM_WIDTH, N_BRANCH * D_MODEL)
IN_WIDTH = MLA_Q_LORA + MLA_KV_LORA + MLA_ROPE + 3 * NA_WIDTH + 2 * CM_WIDTH + N_BRANCH * D_MODEL

D_FF = 2816
N_EXPERTS = 8
TOP_K = 2
D_FF_EXPERT = 3584
MOE_BLOCK = 512
N_DENSE = (DEPTH + 1) // 2
N_MOE = DEPTH // 2

kernel_name = 'hybrid_mla_natten_chunkmlp_moe_dit'


def rms_norm(x, g):
    xf = x.astype(jnp.float32)
    y = xf * lax.rsqrt(jnp.mean(xf * xf, axis=-1, keepdims=True) + EPS)
    return (y * g.astype(jnp.float32)).astype(x.dtype)


def layer_norm(x, g, b):
    xf = x.astype(jnp.float32)
    mu = jnp.mean(xf, axis=-1, keepdims=True)
    xc = xf - mu
    y = xc * lax.rsqrt(jnp.mean(xc * xc, axis=-1, keepdims=True) + EPS)
    return (y * g.astype(jnp.float32) + b.astype(jnp.float32)).astype(x.dtype)


def split_in(p):
    return jnp.split(p, np.cumsum(IN_SPLITS)[:-1], axis=-1)


def axial_rope(rows, dtype):
    half = MLA_ROPE // 2
    inv = ROPE_BASE ** (-(jnp.arange(0, half, 2, dtype=jnp.float32) / half))
    t = jnp.arange(rows * GRID_W)
    ang_r = (t // GRID_W).astype(jnp.float32)[:, None] * inv
    ang_c = (t % GRID_W).astype(jnp.float32)[:, None] * inv
    ang = jnp.concatenate([ang_r, ang_r, ang_c, ang_c], axis=-1)[:, None, :]
    return jnp.cos(ang).astype(dtype), jnp.sin(ang).astype(dtype)


def rope_2d(x, cos, sin):
    half = MLA_ROPE // 2
    quarter = half // 2
    def rot(z):
        return jnp.concatenate([-z[..., quarter:], z[..., :quarter]], axis=-1)
    rotated = jnp.concatenate([rot(x[..., :half]), rot(x[..., half:])], axis=-1)
    return x * cos + rotated * sin


def mla_q(cq, g_q, w_uq, cos, sin):
    b, l, _ = cq.shape
    q = (rms_norm(cq, g_q) @ w_uq).reshape(b, l, MLA_HEADS, MLA_QK)
    q_nope, q_rope = q[..., :MLA_NOPE], q[..., MLA_NOPE:]
    if cos is not None:
        q_rope = rope_2d(q_rope, cos, sin)
    return jnp.concatenate([q_nope, q_rope], axis=-1)


def mla_kv(ckv, k_rope, g_kv, w_ukv, cos, sin):
    b, l, _ = ckv.shape
    kv = (rms_norm(ckv, g_kv) @ w_ukv).reshape(b, l, MLA_HEADS, MLA_NOPE + MLA_V)
    k_nope, v = kv[..., :MLA_NOPE], kv[..., MLA_NOPE:]
    kr = k_rope[:, :, None, :]
    if cos is not None:
        kr = rope_2d(kr, cos, sin)
    k = jnp.concatenate([k_nope, jnp.broadcast_to(kr, (b, l, MLA_HEADS, MLA_ROPE))], axis=-1)
    return k, v


def dense_attention(q, k, v):
    s = jnp.einsum('bqhd,bkhd->bhqk', q, k).astype(jnp.float32) * (q.shape[-1] ** -0.5)
    p = jax.nn.softmax(s, axis=-1).astype(v.dtype)
    o = jnp.einsum('bhqk,bkhd->bqhd', p, v)
    return o.reshape(o.shape[0], o.shape[1], -1)


def mla_latent_attention(q, k_all, v_all):
    b, s_len, h, dq = q.shape
    nb = s_len // Q_BLOCK
    qb = q.reshape(b, nb, Q_BLOCK, h, dq).transpose(1, 0, 2, 3, 4)
    scale = dq ** -0.5
    def block(qi):
        s = jnp.einsum('bqhd,bkhd->bhqk', qi, k_all).astype(jnp.float32) * scale
        p = jax.nn.softmax(s, axis=-1).astype(v_all.dtype)
        return jnp.einsum('bhqk,bkhd->bqhd', p, v_all)
    o = lax.map(block, qb)
    return o.transpose(1, 0, 2, 3, 4).reshape(b, s_len, h * MLA_V)


def na_latent_attention(q, k, v, k_ctx, v_ctx, rpb):
    b, s_len, h, hd = q.shape
    rows = s_len // GRID_W
    kr = min(NA_WIN_ROWS, rows)
    nblk = GRID_W // NA_COL_BLOCK
    scale = hd ** -0.5
    qg = q.reshape(b, rows, nblk, NA_COL_BLOCK, h, hd)
    kg = k.reshape(b, rows, GRID_W, h, hd)
    vg = v.reshape(b, rows, GRID_W, h, hd)
    blk = np.arange(nblk)
    span_start = np.clip(blk * NA_COL_BLOCK - NA_WIN_COLS // 2, 0, GRID_W - NA_COL_SPAN)
    span_cols = span_start[:, None] + np.arange(NA_COL_SPAN)
    q_cols = blk[:, None] * NA_COL_BLOCK + np.arange(NA_COL_BLOCK)
    win_start = np.clip(q_cols - NA_WIN_COLS // 2, 0, GRID_W - NA_WIN_COLS)
    col_ok = jnp.asarray((span_cols[:, None, :] >= win_start[:, :, None]) & (span_cols[:, None, :] < win_start[:, :, None] + NA_WIN_COLS))
    dc_idx = jnp.asarray(np.clip(span_cols[:, None, :] - q_cols[:, :, None] + NA_WIN_COLS - 1, 0, 2 * NA_WIN_COLS - 2))
    n_win = kr * NA_COL_SPAN
    def row_step(r):
        rs = jnp.clip(r - NA_WIN_ROWS // 2, 0, rows - kr)
        kb = lax.dynamic_slice_in_dim(kg, rs, kr, axis=1)[:, :, span_cols]
        vb = lax.dynamic_slice_in_dim(vg, rs, kr, axis=1)[:, :, span_cols]
        qr = lax.dynamic_index_in_dim(qg, r, axis=1, keepdims=False)
        s_win = jnp.einsum('bmqhd,bamkhd->bhmqak', qr, kb).astype(jnp.float32) * scale
        ri = rs + jnp.arange(kr) - r + NA_WIN_ROWS - 1
        bias = rpb[:, ri[None, None, :, None], dc_idx[:, :, None, :]]
        s_win = jnp.where(col_ok[:, :, None, :], s_win + bias[None].astype(jnp.float32), NEG_INF)
        s_ctx = jnp.einsum('bmqhd,bchd->bhmqc', qr, k_ctx).astype(jnp.float32) * scale
        s = jnp.concatenate([s_win.reshape(b, h, nblk, NA_COL_BLOCK, n_win), s_ctx], axis=-1)
        p = jax.nn.softmax(s, axis=-1).astype(v.dtype)
        p_win = p[..., :n_win].reshape(b, h, nblk, NA_COL_BLOCK, kr, NA_COL_SPAN)
        return (jnp.einsum('bhmqak,bamkhd->bmqhd', p_win, vb)
                + jnp.einsum('bhmqc,bchd->bmqhd', p[..., n_win:], v_ctx))
    o = lax.map(row_step, jnp.arange(rows))
    return o.transpose(1, 0, 2, 3, 4, 5).reshape(b, s_len, h * hd)


def chunk_mlp(u, v, g_v, b_v, w_sp, b_sp):
    b, l, _ = v.shape
    vn = layer_norm(v, g_v, b_v).reshape(b, l // CM_CHUNK, CM_CHUNK, CM_GROUPS, CM_GROUP_DIM)
    s = jnp.einsum('gpq,bnqgc->bnpgc', w_sp, vn) + b_sp.T[None, None, :, :, None]
    return u * s.reshape(b, l, CM_WIDTH)


def merge_branches(y_mla, y_na, y_cm, gate_logits, w_br, w_out):
    b, l, _ = y_mla.shape
    g = jax.nn.sigmoid(gate_logits.astype(jnp.float32)).astype(y_mla.dtype).reshape(b, l, N_BRANCH, D_MODEL)
    o1, o2 = MLA_WIDTH, MLA_WIDTH + NA_WIDTH
    z = (g[:, :, 0] * (y_mla @ w_br[:o1]) + g[:, :, 1] * (y_na @ w_br[o1:o2]) + g[:, :, 2] * (y_cm @ w_br[o2:]))
    return z @ w_out


def token_mixer(n_x, n_c, cos, sin, with_ctx_out, w_in, g_q, w_uq, g_kv, w_ukv, rpb, g_v, b_v, w_sp, b_sp, w_br, w_out):
    def heads(t):
        return t.reshape(t.shape[0], t.shape[1], NA_HEADS, NA_HEAD_DIM)
    cq_x, ckv_x, kr_x, naq_x, nak_x, nav_x, u_x, v_x, gl_x = split_in(n_x @ w_in)
    cq_c, ckv_c, kr_c, naq_c, nak_c, nav_c, u_c, v_c, gl_c = split_in(n_c @ w_in)
    k_x, vv_x = mla_kv(ckv_x, kr_x, g_kv, w_ukv, cos, sin)
    k_c, vv_c = mla_kv(ckv_c, kr_c, g_kv, w_ukv, None, None)
    q_x = mla_q(cq_x, g_q, w_uq, cos, sin)
    y_mla_x = mla_latent_attention(q_x, jnp.concatenate([k_c, k_x], axis=1), jnp.concatenate([vv_c, vv_x], axis=1))
    y_na_x = na_latent_attention(heads(naq_x), heads(nak_x), heads(nav_x), heads(nak_c), heads(nav_c), rpb)
    y_cm_x = chunk_mlp(u_x, v_x, g_v, b_v, w_sp, b_sp)
    out_x = merge_branches(y_mla_x, y_na_x, y_cm_x, gl_x, w_br, w_out)
    if not with_ctx_out:
        return out_x, None
    q_c = mla_q(cq_c, g_q, w_uq, None, None)
    y_mla_c = dense_attention(q_c, k_c, vv_c)
    y_na_c = dense_attention(heads(naq_c), heads(nak_c), heads(nav_c))
    y_cm_c = chunk_mlp(u_c, v_c, g_v, b_v, w_sp, b_sp)
    out_c = merge_branches(y_mla_c, y_na_c, y_cm_c, gl_c, w_br, w_out)
    return out_x, out_c


def swiglu(t, w1, w3, w2):
    return (jax.nn.silu(t @ w1) * (t @ w3)) @ w2


def moe_swiglu(t, w_router, w1, w3, w2):
    b, l, d = t.shape
    n_tok = b * l
    tf = t.reshape(n_tok, d)
    logits = (tf @ w_router).astype(jnp.float32)
    top_logit, top_e = lax.top_k(logits, TOP_K)
    top_w = jax.nn.softmax(top_logit, axis=-1).astype(t.dtype)
    n_asg = n_tok * TOP_K
    e_flat = top_e.reshape(n_asg)
    tok_flat = jnp.arange(n_asg) // TOP_K
    order = jnp.argsort(e_flat)
    e_s, tok_s, w_s = e_flat[order], tok_flat[order], top_w.reshape(n_asg)[order]
    counts = jnp.bincount(e_flat, length=N_EXPERTS)
    starts = jnp.cumsum(counts) - counts
    padded = (counts + MOE_BLOCK - 1) // MOE_BLOCK * MOE_BLOCK
    pad_end = jnp.cumsum(padded)
    pad_start = pad_end - padded
    dest = pad_start[e_s] + jnp.arange(n_asg) - starts[e_s]
    n_blocks = -(-n_asg // MOE_BLOCK) + N_EXPERTS
    n_pad = n_blocks * MOE_BLOCK
    pad_tok = jnp.full((n_pad,), n_tok, jnp.int32).at[dest].set(tok_s)
    pad_w = jnp.zeros((n_pad,), t.dtype).at[dest].set(w_s)
    blk_expert = jnp.minimum(jnp.searchsorted(pad_end, jnp.arange(n_blocks) * MOE_BLOCK, side='right'), N_EXPERTS - 1)
    x_pad = jnp.concatenate([tf, jnp.zeros((1, d), t.dtype)], axis=0)[pad_tok].reshape(n_blocks, MOE_BLOCK, d)
    def expert_block(args):
        xb, e = args
        return swiglu(xb, w1[e], w3[e], w2[e])
    y = lax.map(expert_block, (x_pad, blk_expert)).reshape(n_pad, d) * pad_w[:, None]
    out = jax.ops.segment_sum(y, pad_tok, num_segments=n_tok + 1)[:n_tok]
    return out.reshape(b, l, d)


def channel_mixer(t, layer, w_ffn1, w_ffn3, w_ffn2, w_router, w_moe1, w_moe3, w_moe2):
    i = layer // 2
    if layer % 2 == 0:
        return swiglu(t, w_ffn1[i], w_ffn3[i], w_ffn2[i])
    return moe_swiglu(t, w_router[i], w_moe1[i], w_moe3[i], w_moe2[i])


def setup_inputs(seed: int = 0) -> dict:
    key = jax.random.key(seed)
    ks = iter(jax.random.split(key, 32))
    def nrm(shape, scale):
        return jax.random.normal(next(ks), shape, jnp.float32) * scale
    def gain(shape):
        return 1.0 + nrm(shape, 0.02)
    L = DEPTH
    return {
        'x': nrm((BATCH, SEQ, D_MODEL), 1.0),
        'c': nrm((BATCH, D_MODEL), 1.0),
        'ctx': nrm((BATCH, CTX_LEN, D_MODEL), 1.0),
        'c_ctx': nrm((D_MODEL,), 1.0),
        'w_mod': nrm((L, D_MODEL, N_MOD * D_MODEL), D_MODEL ** -0.5),
        'b_mod': nrm((L, N_MOD * D_MODEL), 0.02),
        'g_pre_mix': gain((L, D_MODEL)),
        'g_post_mix': gain((L, D_MODEL)),
        'g_pre_ffn': gain((L, D_MODEL)),
        'g_post_ffn': gain((L, D_MODEL)),
        'w_in': nrm((L, D_MODEL, IN_WIDTH), D_MODEL ** -0.5),
        'g_q': gain((L, MLA_Q_LORA)),
        'w_uq': nrm((L, MLA_Q_LORA, MLA_HEADS * MLA_QK), MLA_Q_LORA ** -0.5),
        'g_kv': gain((L, MLA_KV_LORA)),
        'w_ukv': nrm((L, MLA_KV_LORA, MLA_HEADS * (MLA_NOPE + MLA_V)), MLA_KV_LORA ** -0.5),
        'rpb': nrm((L, NA_HEADS, 2 * NA_WIN_ROWS - 1, 2 * NA_WIN_COLS - 1), 0.1),
        'g_v': gain((L, CM_WIDTH)),
        'b_v': nrm((L, CM_WIDTH), 0.02),
        'w_sp': nrm((L, CM_GROUPS, CM_CHUNK, CM_CHUNK), CM_CHUNK ** -0.5),
        'b_sp': nrm((L, CM_GROUPS, CM_CHUNK), 0.02),
        'w_br': nrm((L, MIX_WIDTH, D_MODEL), D_MODEL ** -0.5),
        'w_out': nrm((L, D_MODEL, D_MODEL), D_MODEL ** -0.5),
        'w_ffn1': nrm((N_DENSE, D_MODEL, D_FF), D_MODEL ** -0.5),
        'w_ffn3': nrm((N_DENSE, D_MODEL, D_FF), D_MODEL ** -0.5),
        'w_ffn2': nrm((N_DENSE, D_FF, D_MODEL), D_FF ** -0.5),
        'w_router': nrm((N_MOE, D_MODEL, N_EXPERTS), D_MODEL ** -0.5),
        'w_moe1': nrm((N_MOE, N_EXPERTS, D_MODEL, D_FF_EXPERT), D_MODEL ** -0.5),
        'w_moe3': nrm((N_MOE, N_EXPERTS, D_MODEL, D_FF_EXPERT), D_MODEL ** -0.5),
        'w_moe2': nrm((N_MOE, N_EXPERTS, D_FF_EXPERT, D_MODEL), D_FF_EXPERT ** -0.5),
    }


def reference(x, c, ctx, c_ctx, w_mod, b_mod, g_pre_mix, g_post_mix, g_pre_ffn, g_post_ffn, w_in, g_q, w_uq, g_kv, w_ukv, rpb, g_v, b_v, w_sp, b_sp, w_br, w_out, w_ffn1, w_ffn3, w_ffn2, w_router, w_moe1, w_moe3, w_moe2):
    b, s_len, d = x.shape
    rows = s_len // GRID_W
    cos, sin = axial_rope(rows, x.dtype)
    sc = jax.nn.silu(c)
    scc = jax.nn.silu(c_ctx)
    h_x, h_c = x, ctx
    for l in range(DEPTH):
        last = l == DEPTH - 1
        mod_x = (sc @ w_mod[l] + b_mod[l]).reshape(b, N_MOD, 1, d)
        mod_c = (scc @ w_mod[l] + b_mod[l]).reshape(N_MOD, d)
        n_x = rms_norm(h_x, g_pre_mix[l]) * (1 + mod_x[:, 1]) + mod_x[:, 0]
        n_c = rms_norm(h_c, g_pre_mix[l]) * (1 + mod_c[1]) + mod_c[0]
        o_x, o_c = token_mixer(n_x, n_c, cos, sin, not last, w_in[l], g_q[l], w_uq[l], g_kv[l], w_ukv[l], rpb[l], g_v[l], b_v[l], w_sp[l], b_sp[l], w_br[l], w_out[l])
        h_x = h_x + mod_x[:, 2] * rms_norm(o_x, g_post_mix[l])
        f_x = channel_mixer(rms_norm(h_x, g_pre_ffn[l]) * (1 + mod_x[:, 4]) + mod_x[:, 3], l, w_ffn1, w_ffn3, w_ffn2, w_router, w_moe1, w_moe3, w_moe2)
        h_x = h_x + mod_x[:, 5] * rms_norm(f_x, g_post_ffn[l])
        if not last:
            h_c = h_c + mod_c[2] * rms_norm(o_c, g_post_mix[l])
            f_c = channel_mixer(rms_norm(h_c, g_pre_ffn[l]) * (1 + mod_c[4]) + mod_c[3], l, w_ffn1, w_ffn3, w_ffn2, w_router, w_moe1, w_moe3, w_moe2)
            h_c = h_c + mod_c[5] * rms_norm(f_c, g_post_ffn[l])
    return h_x
```

```cpp
#include <hip/hip_runtime.h>
#include <stdint.h>
#include <stdio.h>

#define LAS __attribute__((address_space(3)))
#define GAS __attribute__((address_space(1)))
typedef unsigned short bf16_t;
typedef short bf16x8 __attribute__((ext_vector_type(8)));
typedef short s16x4 __attribute__((ext_vector_type(4)));
typedef float f32x4 __attribute__((ext_vector_type(4)));
typedef float f32x2 __attribute__((ext_vector_type(2)));
typedef float f32x16 __attribute__((ext_vector_type(16)));
typedef unsigned u32x4 __attribute__((ext_vector_type(4)));
typedef unsigned u32x2 __attribute__((ext_vector_type(2)));

constexpr int NB = 8, SEQ = 4096, DM = 1024, CTX = 256, NLAYER = 2;
constexpr int MX = NB * SEQ;
constexpr int MC = NB * CTX;
constexpr int MT = MX + MC;
constexpr int LK = CTX + SEQ;
constexpr int INW = 5024;
constexpr int DFF = 2816, DFE = 3584, NEXP = 8;
constexpr float EPS = 1e-6f;
constexpr float LOG2E = 1.4426950408889634f;
constexpr int NWAVES = 8, NTHR = 512;

constexpr size_t MiB = 1u << 20;
constexpr size_t WS_CTL = 0;
constexpr size_t CTL_ZERO_BYTES = 1 * MiB;
constexpr size_t WS_TAB = 1 * MiB;
constexpr size_t WS_LTOK = WS_TAB + 65536;
constexpr size_t WS_LW = WS_LTOK + 8 * 32768 * 4;
constexpr size_t WS_SSQ = WS_LW + 8 * 32768 * 4;
constexpr size_t WS_W0 = 6 * MiB;
constexpr size_t SZ_WIN = (size_t)2048 * 1024 * 2;
constexpr size_t SZ_WGL = (size_t)3072 * 1024 * 2;
constexpr size_t SZ_WUQ = (size_t)768 * 384 * 2;
constexpr size_t SZ_WUKV = (size_t)1024 * 256 * 2;
constexpr size_t SZ_WBR = (size_t)1024 * 1024 * 2;
constexpr size_t SZ_WOUT = (size_t)1024 * 1024 * 2;
constexpr size_t SZ_WSP = (size_t)4 * 128 * 128 * 2;
constexpr size_t OFF_WIN = 0, OFF_WGL = OFF_WIN + SZ_WIN, OFF_WUQ = OFF_WGL + SZ_WGL, OFF_WUKV = OFF_WUQ + SZ_WUQ, OFF_WBR = OFF_WUKV + SZ_WUKV,
                 OFF_WOUT = OFF_WBR + SZ_WBR, OFF_WSP = OFF_WOUT + SZ_WOUT, SZ_LAYERW = OFF_WSP + SZ_WSP;
constexpr size_t WS_WF13 = WS_W0 + 2 * SZ_LAYERW;
constexpr size_t WS_WF2 = WS_WF13 + (size_t)5632 * 1024 * 2;
constexpr size_t WS_HC = WS_WF2 + (size_t)1024 * 2816 * 2;
constexpr size_t WS_N = WS_HC + (size_t)MC * DM * 4;
constexpr size_t WS_ARENA = WS_N + (size_t)MT * DM * 2;
constexpr size_t WS_HB1 = WS_W0;
constexpr size_t WS_N8M = WS_N + 36 * MiB;
static_assert(WS_HB1 + (size_t)MX * 1024 * 2 <= WS_N8M && WS_N8M + (size_t)MX * 1024 <= WS_ARENA, "expert-layer h and fp8 input fit below the arena");
constexpr size_t WS_Y = WS_ARENA;
constexpr size_t WS_CQ = WS_Y + (size_t)MT * 1024 * 2;
constexpr size_t WS_CKV = WS_CQ + (size_t)MT * 384 * 2;
constexpr size_t WS_U = WS_CKV + (size_t)MT * 256 * 2;
constexpr size_t WS_V = WS_U + (size_t)MT * 256 * 2;
constexpr size_t WS_NAQ = WS_V + (size_t)MT * 256 * 2;
constexpr size_t WS_NAK = WS_NAQ + (size_t)MT * 256 * 2;
constexpr size_t WS_NAVT = WS_NAK + (size_t)MT * 256 * 2;
constexpr size_t WS_Q = WS_NAVT + (size_t)NB * 256 * LK * 2;
constexpr size_t WS_K = WS_Q + (size_t)MT * 768 * 2;
constexpr size_t WS_VT = WS_K + (size_t)NB * 8 * LK * 96 * 2;
constexpr size_t WS_GSCR = WS_VT + (size_t)NB * 8 * 64 * LK * 2;
constexpr size_t WS_MIX_END = WS_GSCR + (size_t)256 * 262144;
constexpr size_t WS_ZP = WS_NAQ;
constexpr size_t WS_OP = WS_Y;
constexpr size_t WS_FP = WS_VT;
static_assert(WS_ZP + (size_t)3 * MC * 1024 * 2 <= WS_Q && WS_CQ + (size_t)MT * 1024 * 2 <= WS_NAQ, "ZP clear of O");
static_assert(WS_FP >= WS_ARENA + (size_t)MT * DFF * 2 + (size_t)MT * 1024 * 2, "FP clear of HMID and F");
constexpr size_t WS_HB = WS_MIX_END;
constexpr size_t WS_END = WS_HB + (size_t)MX * 1024 * 2;
constexpr size_t WS_O = WS_CQ;
constexpr size_t WS_Z = WS_Q;
static_assert(WS_O + (size_t)MT * 1024 * 2 <= WS_NAQ, "O alias");
static_assert(WS_Z + (size_t)MT * 1024 * 2 <= WS_VT, "Z alias");
constexpr size_t WS_HMID = WS_ARENA;
constexpr size_t WS_F = WS_HMID + (size_t)MT * DFF * 2;
constexpr size_t WS_Y2 = WS_ARENA;
constexpr size_t WS_WM13 = WS_O + (size_t)MT * 1024 * 2;
constexpr size_t WS_WM2 = WS_WM13 + (size_t)8 * 7168 * 1024;
constexpr size_t WS_HM = WS_WM2 + (size_t)8 * 1024 * 3584;
static_assert(WS_Y2 + (size_t)MX * 2048 * 2 <= WS_WM13, "Y2 vs WM13");
constexpr size_t HM_TILE_BYTES = (size_t)256 * DFE;
constexpr size_t WS_XG = WS_O;
static_assert((size_t)264 * 256 * 1024 <= (size_t)MT * 1024 * 2, "XG fits the O region");

constexpr int CW_BAR = 1024;
constexpr int CW_CNT = 8192;
constexpr int CW_MOD = 16384;
static_assert((CW_MOD + 2 * 9 * 6144) * 4 <= (int)CTL_ZERO_BYTES, "CTL");

constexpr int LDS_BYTES = 150528;
constexpr int LDS_MISC = 147456;

__device__ __forceinline__ unsigned f2bf(float f) { unsigned u = __builtin_bit_cast(unsigned, f); return (u + 0x7fffu + ((u >> 16) & 1u)) >> 16; }
typedef float pk2_f32x2 __attribute__((ext_vector_type(2))); typedef __bf16 pk2_bf16x2 __attribute__((ext_vector_type(2)));
__device__ __forceinline__ unsigned pk2(float lo, float hi) { pk2_f32x2 v = {lo, hi}; pk2_bf16x2 b = __builtin_convertvector(v, pk2_bf16x2); return __builtin_bit_cast(unsigned, b); }
__device__ __forceinline__ float bf_lo(unsigned w) { return __builtin_bit_cast(float, w << 16); }
__device__ __forceinline__ float bf_hi(unsigned w) { return __builtin_bit_cast(float, w & 0xffff0000u); }
__device__ __forceinline__ float wave_sum(float v) {
#pragma unroll
    for (int o = 1; o < 64; o <<= 1) v += __shfl_xor(v, o);
    return v;
}
__device__ __forceinline__ float fast_exp2(float x) { return __builtin_amdgcn_exp2f(x); }
__device__ __forceinline__ float sigmoidf_(float x) { return __builtin_amdgcn_rcpf(1.0f + fast_exp2(-x * LOG2E)); }
__device__ __forceinline__ int pk4_fp8(float a, float b, float c, float d) { int w = 0; w = __builtin_amdgcn_cvt_pk_fp8_f32(a, b, w, false); w = __builtin_amdgcn_cvt_pk_fp8_f32(c, d, w, true); return w; }
__device__ __forceinline__ float clamp8(float x) { return fminf(fmaxf(x, -440.0f), 440.0f); }
#define LDS_WAIT() asm volatile("s_waitcnt lgkmcnt(0)" ::: "memory")
#define VM_WAIT() asm volatile("s_waitcnt vmcnt(0)" ::: "memory")

#define XB_TMO      128
#define XB_XCNT(j)  (256  + 64 * (j))
#define XB_XSUB(j)  (1280 + 64 * (j))
#define XB_XGEN(j)  (2304 + 64 * (j))
#define XB_TOP      3328
#define XB_TOPGEN   3392
#define XCD_BAR_WORDS 3456
#define XB_SPIN_CAP (1u << 18)
__device__ __forceinline__ unsigned xb_ld(unsigned* p)              { return __hip_atomic_load(p, __ATOMIC_RELAXED, __HIP_MEMORY_SCOPE_AGENT); }
__device__ __forceinline__ unsigned xb_add(unsigned* p, unsigned v) { return __hip_atomic_fetch_add(p, v, __ATOMIC_RELAXED, __HIP_MEMORY_SCOPE_AGENT); }
__device__ __forceinline__ unsigned xb_xcc_id() { return (unsigned)__builtin_amdgcn_s_getreg((3 << 11) | 20) & 0xFu; }
#define XB_SPIN(cond, bar) do { unsigned _sp = 0; while (cond) { __builtin_amdgcn_s_sleep(1); \
    if ((++_sp & 255u) == 0u) { if (xb_ld(&(bar)[XB_TMO])) break; if (_sp > XB_SPIN_CAP) { atomicAdd(&(bar)[XB_TMO], 1u); break; } } } } while (0)
struct XcdBarrier { unsigned* bar; unsigned x; volatile LAS unsigned* st; };
__device__ __forceinline__ XcdBarrier xcd_barrier_post(unsigned* bar, volatile LAS unsigned* st) {
    XcdBarrier b; b.bar = bar; b.x = xb_xcc_id(); b.st = st;
    if (threadIdx.x == 0) (void)xb_add(&bar[XB_XCNT(b.x)], 1u);
    return b;
}
__device__ __forceinline__ void xcd_barrier_complete(unsigned* bar, unsigned x, unsigned& nloc, unsigned& nx) {
    const unsigned G = gridDim.x * gridDim.y * gridDim.z;
    unsigned sum, cnt, mine, sp = 0u;
    for (;;) {
        sum = 0u; cnt = 0u; mine = 0u;
#pragma unroll
        for (unsigned j = 0; j < 16; ++j) { const unsigned c = xb_ld(&bar[XB_XCNT(j)]); sum += c; cnt += (c > 0u) ? 1u : 0u; mine = (j == x) ? c : mine; }
        if (sum == G) break;
        __builtin_amdgcn_s_sleep(1);
        if ((++sp & 255u) == 0u) { if (xb_ld(&bar[XB_TMO])) break; if (sp > XB_SPIN_CAP) { atomicAdd(&bar[XB_TMO], 1u); break; } }
    }
    nloc = mine > 0u ? mine : 1u; nx = cnt > 0u ? cnt : 1u;
}
__device__ __forceinline__ void xcd_barrier(const XcdBarrier& b, const int tid_) {
    asm volatile("s_waitcnt vmcnt(0)" ::: "memory");
    __syncthreads();
    if (tid_ == 0) {
        unsigned* bar = b.bar;
        __builtin_amdgcn_s_waitcnt(0);
        unsigned nloc = b.st[0], nx = b.st[1];
        if (nloc == 0u) { xcd_barrier_complete(bar, b.x, nloc, nx); b.st[0] = nloc; b.st[1] = nx; }
        const unsigned old = xb_add(&bar[XB_XSUB(b.x)], 1u);
        const unsigned gen = old / nloc;
        if (old + 1u == (gen + 1u) * nloc) {
            __builtin_amdgcn_fence(__ATOMIC_RELEASE, "agent");
            asm volatile("s_waitcnt vmcnt(0)" ::: "memory");
            const unsigned og = xb_add(&bar[XB_TOP], 1u);
            const unsigned tg = og / nx;
            if (og + 1u == (tg + 1u) * nx) xb_add(&bar[XB_TOPGEN], 1u);
            else XB_SPIN(xb_ld(&bar[XB_TOPGEN]) == tg, bar);
            __builtin_amdgcn_fence(__ATOMIC_ACQUIRE, "agent");
            xb_add(&bar[XB_XGEN(b.x)], 1u);
            asm volatile("s_waitcnt vmcnt(0)" ::: "memory");
        } else {
            XB_SPIN(xb_ld(&bar[XB_XGEN(b.x)]) == gen, bar);
            __builtin_amdgcn_fence(__ATOMIC_ACQUIRE, "agent");
            asm volatile("s_waitcnt vmcnt(0)" ::: "memory");
        }
    }
    __syncthreads();
}

namespace pg8 {
typedef int v8i_t __attribute__((ext_vector_type(8))); typedef int v4i_t __attribute__((ext_vector_type(4)));
__device__ __forceinline__ v8i_t cat8(bf16x8 a, bf16x8 b) { return __builtin_shufflevector(__builtin_bit_cast(v4i_t, a), __builtin_bit_cast(v4i_t, b), 0, 1, 2, 3, 4, 5, 6, 7); }
constexpr int BM = 256, BK = 64, HALF = 128, HTB = HALF * BK * 2, STAGE_BYTES = 8 * HTB;
__host__ __device__ __forceinline__ int lds_byte(int r, int c) { const int st = (r >> 4) * 2 + (c >> 5), rr = r & 15, cc = c & 31, ob = rr * 64 + cc * 2; return st * 1024 + (ob ^ (((ob >> 9) & 1) << 5)); }
__host__ __device__ __forceinline__ void stage_rc(int b, int& R, int& C) { const int st = b / 1024, sb = b % 1024, swz = sb ^ (((sb >> 9) & 1) << 5); R = (st >> 1) * 16 + swz / 64; C = (st & 1) * 32 + (swz % 64) / 2; }
__host__ __device__ __forceinline__ int perm32(int rho) { const int n = rho >> 4, i = rho & 15; return 8 * (i >> 2) + 4 * n + (i & 3); }

struct Unit { const char* A; const char* B; int nt; int job, pm, pn; int f8; };

template <class Epi, class Sched, bool GATHER, bool FP8 = false, bool MIXED = false>
__device__ __forceinline__ void gemm_phase(LAS unsigned char* lds, const int lda2, const int ldb2, const Sched& S, const Epi& E, const int tid_in) {
    const int tid = tid_in, wid = __builtin_amdgcn_readfirstlane(tid >> 6), lane = tid & 63, wr = wid >> 2, wc = wid & 3, fr = lane & 15, fq = lane >> 4;
    int Rr[2], Cc[2];
    unsigned voffA[2], voffB[2];
#pragma unroll
    for (int i = 0; i < 2; ++i) { int R, C; stage_rc(tid * 16 + i * 8192, R, C); const int Rb = (R & ~31) + perm32(R & 31);
        Rr[i] = R; Cc[i] = C; voffA[i] = (unsigned)(R * lda2 + C * 2); voffB[i] = (unsigned)(Rb * ldb2 + C * 2); }
    const size_t kstep = (size_t)(BK * 2);
    const size_t hstepA = (size_t)HALF * lda2, hstepB = (size_t)HALF * ldb2;
    const unsigned ldsw = (unsigned)wid * 1024u;
    const int aoff = lds_byte(wr * 64 + fr, fq * 8), boff = lds_byte(wc * 32 + fr, fq * 8);
#define PG8_SA(b, h) (((b) * 2 + (h)) * HTB)
#define PG8_SB(b, h) ((4 + (b) * 2 + (h)) * HTB)
#define PG8_STAGE(bufoff, gbase, voff) do { _Pragma("unroll") for (int _i = 0; _i < 2; ++_i) \
        __builtin_amdgcn_global_load_lds((const unsigned*)((const char*)(gbase) + (voff)[_i]), (LAS unsigned*)(lds + (bufoff) + ldsw + _i * 8192), 16, 0, 0); } while (0)
#define PG8_LDA(dst, b, h) do { _Pragma("unroll") for (int m = 0; m < 4; ++m) _Pragma("unroll") for (int k = 0; k < 2; ++k) dst[m][k] = *(const LAS bf16x8*)(lds + PG8_SA(b, h) + aoff + m * 2048 + k * 1024); } while (0)
#define PG8_LDB(dst, b, h) do { _Pragma("unroll") for (int n = 0; n < 2; ++n) _Pragma("unroll") for (int k = 0; k < 2; ++k) dst[n][k] = *(const LAS bf16x8*)(lds + PG8_SB(b, h) + boff + n * 2048 + k * 1024); } while (0)
#define PG8_MMA_F8(ai, bj, At, Bt) do { __builtin_amdgcn_s_setprio(1); \
        _Pragma("unroll") for (int m = 0; m < 4; ++m) _Pragma("unroll") for (int n = 0; n < 2; ++n) \
            asm volatile("s_nop 3\n\tv_mfma_scale_f32_16x16x128_f8f6f4 %0, %1, %2, %0, %3, %3 op_sel_hi:[0,0,0]" : "+v"(acc[ai][bj][m][n]) : "v"(cat8(Bt[n][0], Bt[n][1])), "v"(cat8(At[m][0], At[m][1])), "v"(sc8)); \
        __builtin_amdgcn_s_setprio(0); } while (0)
#define PG8_MMA_BF(ai, bj, At, Bt) do { __builtin_amdgcn_s_setprio(1); \
        _Pragma("unroll") for (int m = 0; m < 4; ++m) _Pragma("unroll") for (int n = 0; n < 2; ++n) _Pragma("unroll") for (int k = 0; k < 2; ++k) \
            acc[ai][bj][m][n] = __builtin_amdgcn_mfma_f32_16x16x32_bf16(Bt[n][k], At[m][k], acc[ai][bj][m][n], 0, 0, 0); \
        __builtin_amdgcn_s_setprio(0); } while (0)
#define PG8_WAIT_V(n) asm volatile("s_waitcnt vmcnt(" #n ")" ::: "memory")
#define PG8_WAIT_L(n) asm volatile("s_waitcnt lgkmcnt(" #n ")" ::: "memory")
#define PG8_BAR __builtin_amdgcn_s_barrier()
#define PG8_SCHED __builtin_amdgcn_sched_barrier(0)
    int sc8 = 0x7f7f7f7f; asm volatile("" : "+v"(sc8));
    Unit cur, nxt; int ui = 0;
    if (!S.next(0, cur)) return;
    f32x4 acc[2][2][4][2];
#pragma unroll
    for (int a = 0; a < 2; ++a)
#pragma unroll
        for (int b = 0; b < 2; ++b)
#pragma unroll
            for (int m = 0; m < 4; ++m)
#pragma unroll
                for (int n = 0; n < 2; ++n) acc[a][b][m][n] = (f32x4){0.f, 0.f, 0.f, 0.f};
    bf16x8 At[4][2], B0[2][2], B1[2][2];
    unsigned gC[2][2], gN[2][2];
    if constexpr (GATHER) {
#pragma unroll
        for (int h = 0; h < 2; ++h)
#pragma unroll
            for (int i = 0; i < 2; ++i) { gC[h][i] = S.a_row(cur, h * HALF + Rr[i]) * (unsigned)lda2 + (unsigned)(Cc[i] * 2); gN[h][i] = gC[h][i]; }
    }
#define PG8_STAGE_A(bufoff, kptr, h, useN) do { if constexpr (GATHER) { unsigned _o[2]; _o[0] = (useN) ? gN[h][0] : gC[h][0]; _o[1] = (useN) ? gN[h][1] : gC[h][1]; PG8_STAGE(bufoff, kptr, _o); } \
        else { PG8_STAGE(bufoff, (kptr) + (h) * hstepA, voffA); } } while (0)
    const char* cA = cur.A; const char* cB = cur.B;
    PG8_STAGE(PG8_SB(0, 0), cB, voffB); PG8_STAGE(PG8_SB(0, 1), cB + hstepB, voffB); PG8_STAGE_A(PG8_SA(0, 0), cA, 0, false); PG8_STAGE_A(PG8_SA(0, 1), cA, 1, false);
    if (wr == 1) PG8_BAR;
    PG8_WAIT_V(2); PG8_BAR;
    PG8_STAGE(PG8_SB(1, 0), cB + kstep, voffB); PG8_STAGE_A(PG8_SA(1, 0), cA + kstep, 0, false); PG8_STAGE(PG8_SB(1, 1), cB + hstepB + kstep, voffB);
    PG8_WAIT_V(6); PG8_BAR;
    for (;;) {
        const bool has_next = S.next(ui + 1, nxt);
        const char* nA = has_next ? nxt.A : cA; const char* nB = has_next ? nxt.B : cB;
        if constexpr (GATHER) {
            if (has_next) {
#pragma unroll
                for (int h = 0; h < 2; ++h)
#pragma unroll
                    for (int i = 0; i < 2; ++i) gN[h][i] = S.a_row(nxt, h * HALF + Rr[i]) * (unsigned)lda2 + (unsigned)(Cc[i] * 2);
            } else {
#pragma unroll
                for (int h = 0; h < 2; ++h)
#pragma unroll
                    for (int i = 0; i < 2; ++i) gN[h][i] = gC[h][i];
            }
        }
        int f8u = 0; if constexpr (MIXED) f8u = __builtin_amdgcn_readfirstlane(cur.f8);
        int nt = cur.nt; asm volatile("" : "+s"(nt));
#define PG8_KLOOP(MMF)         for (int t = 0; t < nt; t += 2) { \
            const bool last = (t == nt - 2); \
            const char* a1 = cA + (size_t)(t + 1) * kstep; \
            const char* a2 = last ? nA : cA + (size_t)(t + 2) * kstep; const char* b2 = last ? nB : cB + (size_t)(t + 2) * kstep; \
            const char* a3 = a2 + kstep; const char* b3 = b2 + kstep; \
              \
            PG8_LDB(B0, 0, 0); PG8_LDB(B1, 0, 1); PG8_SCHED; PG8_LDA(At, 0, 0); PG8_STAGE_A(PG8_SA(1, 1), a1, 1, false); \
            PG8_WAIT_V(8); PG8_WAIT_L(0); PG8_BAR; MMF(0, 0, At, B0); MMF(0, 1, At, B1); PG8_BAR; PG8_SCHED; \
              \
            PG8_LDA(At, 0, 1); PG8_STAGE(PG8_SB(0, 0), b2, voffB); PG8_STAGE(PG8_SB(0, 1), b2 + hstepB, voffB); PG8_STAGE_A(PG8_SA(0, 0), a2, 0, last); \
            PG8_WAIT_V(8); PG8_WAIT_L(0); PG8_BAR; MMF(1, 0, At, B0); MMF(1, 1, At, B1); PG8_BAR; PG8_SCHED; \
              \
            PG8_LDB(B0, 1, 0); PG8_LDB(B1, 1, 1); PG8_SCHED; PG8_LDA(At, 1, 0); PG8_STAGE_A(PG8_SA(0, 1), a2, 1, last); \
            PG8_WAIT_V(8); PG8_WAIT_L(0); PG8_BAR; MMF(0, 0, At, B0); MMF(0, 1, At, B1); PG8_BAR; PG8_SCHED; \
              \
            PG8_LDA(At, 1, 1); PG8_STAGE(PG8_SB(1, 0), b3, voffB); PG8_STAGE(PG8_SB(1, 1), b3 + hstepB, voffB); PG8_STAGE_A(PG8_SA(1, 0), a3, 0, last); \
            PG8_WAIT_V(8); PG8_WAIT_L(0); PG8_BAR; MMF(1, 0, At, B0); MMF(1, 1, At, B1); PG8_BAR; PG8_SCHED; \
        }
        if constexpr (MIXED) { if (f8u) { PG8_KLOOP(PG8_MMA_F8) } else { PG8_KLOOP(PG8_MMA_BF) } }
        else if constexpr (FP8) { PG8_KLOOP(PG8_MMA_F8) } else { PG8_KLOOP(PG8_MMA_BF) }
#undef PG8_KLOOP
        if (wr == 0) PG8_BAR;
#define PG8_ACC8(a_, b_) "+v"(acc[a_][b_][0][0]), "+v"(acc[a_][b_][0][1]), "+v"(acc[a_][b_][1][0]), "+v"(acc[a_][b_][1][1]), "+v"(acc[a_][b_][2][0]), "+v"(acc[a_][b_][2][1]), "+v"(acc[a_][b_][3][0]), "+v"(acc[a_][b_][3][1])
        asm volatile("s_nop 15\n\ts_nop 15" : PG8_ACC8(0, 0), PG8_ACC8(0, 1) :: "memory");
        asm volatile("" : PG8_ACC8(1, 0), PG8_ACC8(1, 1) :: "memory");
#undef PG8_ACC8
        { int fr_ = fr, fq_ = fq; asm volatile("" : "+v"(fr_), "+v"(fq_));
          E(acc, cur, wr, wc, fr_, fq_); }
        if (!has_next) break;
#pragma unroll
        for (int a = 0; a < 2; ++a)
#pragma unroll
            for (int b = 0; b < 2; ++b)
#pragma unroll
                for (int m = 0; m < 4; ++m)
#pragma unroll
                    for (int n = 0; n < 2; ++n) acc[a][b][m][n] = (f32x4){0.f, 0.f, 0.f, 0.f};
        cur = nxt; cA = nA; cB = nB; ++ui;
        if constexpr (GATHER) {
#pragma unroll
            for (int h = 0; h < 2; ++h)
#pragma unroll
                for (int i = 0; i < 2; ++i) gC[h][i] = gN[h][i];
        }
        if (wr == 1) PG8_BAR;
    }
    PG8_WAIT_V(0);
    PG8_BAR;
#undef PG8_SA
#undef PG8_SB
#undef PG8_STAGE
#undef PG8_STAGE_A
#undef PG8_LDA
#undef PG8_LDB
#undef PG8_MMA_F8
#undef PG8_MMA_BF
#undef PG8_WAIT_V
#undef PG8_WAIT_L
#undef PG8_BAR
#undef PG8_SCHED
}
}
typedef f32x4 AccT[2][2][4][2];

struct Frame {
    LAS unsigned char* lds;
    volatile LAS unsigned* MISC;
    unsigned* ctl;
    unsigned char* ws;
    float* out;
    int tid, lane, wave, vcu, G;
    int hm_tiles;
};
enum { IN_X = 0, IN_C, IN_CTX, IN_CCTX, IN_WMOD, IN_BMOD, IN_GPREMIX, IN_GPOSTMIX, IN_GPREFFN, IN_GPOSTFFN, IN_WIN, IN_GQ, IN_WUQ, IN_GKV, IN_WUKV, IN_RPB,
       IN_GV, IN_BV, IN_WSP, IN_BSP, IN_WBR, IN_WOUT, IN_WFFN1, IN_WFFN3, IN_WFFN2, IN_WROUTER, IN_WMOE1, IN_WMOE3, IN_WMOE2 };
constexpr int MI_CNT = 16, MI_TB = 24, MI_IN = 64;

__device__ __forceinline__ bf16_t* wsb(const Frame& F, size_t off) { return (bf16_t*)(F.ws + off); }
__device__ __forceinline__ const float* inp(const Frame& F, int i) {
    const unsigned lo = F.MISC[MI_IN + 2 * i], hi = F.MISC[MI_IN + 2 * i + 1];
    return (const float*)(((unsigned long long)(unsigned)__builtin_amdgcn_readfirstlane((int)hi) << 32) | (unsigned long long)(unsigned)__builtin_amdgcn_readfirstlane((int)lo));
}
__device__ __forceinline__ bf16_t* layer_w(const Frame& F, int l, size_t off) { return (bf16_t*)(F.ws + WS_W0 + (size_t)l * SZ_LAYERW + off); }

__device__ __forceinline__ void static_tile(int L, int nM, int nN, int& pm, int& pn) {
    const int nwg = nM * nN; int wgid = L;
    { const int q = nwg / 8, r = nwg % 8, xcd = wgid % 8, off = wgid / 8; wgid = (xcd < r ? xcd * (q + 1) : r * (q + 1) + (xcd - r) * q) + off; }
    const int nig = 8 * nN, gid = wgid / nig, fm = gid * 8, gsz = (nM - fm) < 8 ? (nM - fm) : 8;
    const int w = wgid % nig;
    if (gsz == 8) { pm = fm + (w & 7); pn = w >> 3; } else { pm = fm + (w % gsz); pn = w / gsz; }
}
__device__ __forceinline__ u32x4 pack8(const f32x4 a, const f32x4 b) { u32x4 w; w.x = pk2(a[0], a[1]); w.y = pk2(a[2], a[3]); w.z = pk2(b[0], b[1]); w.w = pk2(b[2], b[3]); return w; }
__device__ __forceinline__ void row_b_pos(int r, int& b, int& pos, bool& latent) {
    if (r < MX) { b = r >> 12; pos = CTX + (r & 4095); latent = true; } else { const int rc = r - MX; b = rc >> 8; pos = rc & 255; latent = false; }
}

struct SchedPlain {
    const char* A; const char* B; int lda2, ldb2, nt, nM, nN, G, c;
    __device__ __forceinline__ bool next(int i, pg8::Unit& u) const {
        const int L = i * G + c; if (L >= nM * nN) return false;
        int pm, pn; static_tile(L, nM, nN, pm, pn);
        u.A = A + (size_t)pm * 256 * lda2; u.B = B + (size_t)pn * 256 * ldb2; u.nt = nt; u.job = 0; u.pm = pm; u.pn = pn; return true;
    }
};
struct EpiPlain {
    bf16_t* O; int ld;
    __device__ __forceinline__ void operator()(const AccT& acc, const pg8::Unit& u, int wr, int wc, int fr, int fq) const {
#pragma unroll
        for (int ai = 0; ai < 2; ++ai)
#pragma unroll
            for (int m = 0; m < 4; ++m) { bf16_t* rowp = O + (size_t)(u.pm * 256 + ai * 128 + wr * 64 + m * 16 + fr) * ld + u.pn * 256 + wc * 32 + fq * 8;
#pragma unroll
                for (int bj = 0; bj < 2; ++bj) *(u32x4*)(rowp + bj * 128) = pack8(acc[ai][bj][m][0], acc[ai][bj][m][1]); }
    }
};

struct SchedG1 {
    const char* N; const char* W; int G, c, layer;
    __device__ __forceinline__ bool next(int i, pg8::Unit& u) const {
        int L = i * G + c; u.nt = 16;
        if (L < 896) { int pm, pn; static_tile(L, 128, 7, pm, pn); u.A = N + (size_t)pm * 256 * 2048; u.B = W + (size_t)pn * 256 * 2048; u.job = 0; u.pm = pm; u.pn = pn; return true; }
        L -= 896;
        if (L < 128) { u.A = W + (size_t)1792 * 2048; u.B = N + (size_t)L * 256 * 2048; u.job = 1; u.pm = 0; u.pn = L; return true; }
        L -= 128;
        if (layer == 0) {
            if (L < 56) { const int pm = 128 + L / 7, pn = L % 7; u.A = N + (size_t)pm * 256 * 2048; u.B = W + (size_t)pn * 256 * 2048; u.job = 0; u.pm = pm; u.pn = pn; return true; }
            L -= 56;
        } else {
            if (L < 24) { const int pm = 128 + L / 3, q = L % 3, pn = (q == 0) ? 0 : (q == 1 ? 2 : 6); u.A = N + (size_t)pm * 256 * 2048; u.B = W + (size_t)pn * 256 * 2048; u.job = 0; u.pm = pm; u.pn = pn; return true; }
            L -= 24;
        }
        if (L < 8) { u.A = W + (size_t)1792 * 2048; u.B = N + (size_t)(128 + L) * 256 * 2048; u.job = 1; u.pm = 0; u.pn = 128 + L; return true; }
        return false;
    }
};
__device__ __forceinline__ void rope8(f32x4& v0, f32x4& v1, int fq, int s, const float* TAB) {
    const int p = (fq < 2) ? (s >> 6) : (s & 63);
    const f32x4* t = (const f32x4*)(TAB + p * 16);
    const f32x4 t0 = t[0], t1 = t[1], t2 = t[2], t3 = t[3];
    f32x4 p0, p1;
#pragma unroll
    for (int j = 0; j < 4; ++j) { p0[j] = __shfl_xor(v0[j], 16); p1[j] = __shfl_xor(v1[j], 16); }
    const float sg = (fq & 1) ? 1.0f : -1.0f;
    v0[0] = v0[0] * t0[0] + sg * p0[0] * t0[1]; v0[1] = v0[1] * t0[2] + sg * p0[1] * t0[3];
    v0[2] = v0[2] * t1[0] + sg * p0[2] * t1[1]; v0[3] = v0[3] * t1[2] + sg * p0[3] * t1[3];
    v1[0] = v1[0] * t2[0] + sg * p1[0] * t2[1]; v1[1] = v1[1] * t2[2] + sg * p1[1] * t2[3];
    v1[2] = v1[2] * t3[0] + sg * p1[2] * t3[1]; v1[3] = v1[3] * t3[2] + sg * p1[3] * t3[3];
}
struct EpiG1 {
    bf16_t *CKV, *NAQ, *NAK, *U, *V, *CQ, *K, *NAVT; float* SSQ; const float* TAB;
    __device__ __forceinline__ void operator()(const AccT& acc, const pg8::Unit& u, int wr, int wc, int fr, int fq) const {
        if (u.job == 1) {
            const int tn = u.pn; int b, pos0; if (tn < 128) { b = tn >> 4; pos0 = CTX + (tn & 15) * 256; } else { b = tn - 128; pos0 = 0; }
#pragma unroll
            for (int ai = 0; ai < 2; ++ai)
#pragma unroll
                for (int m = 0; m < 4; ++m) { const int f = ai * 128 + wr * 64 + m * 16 + fr;
                    bf16_t* rowp = NAVT + ((size_t)(b * 256 + f) * LK + pos0) + wc * 32 + fq * 8;
#pragma unroll
                    for (int bj = 0; bj < 2; ++bj) *(u32x4*)(rowp + bj * 128) = pack8(acc[ai][bj][m][0], acc[ai][bj][m][1]); }
            return;
        }
        const int pn = u.pn; const int row0 = u.pm * 256 + wr * 64 + fr;
        if (pn >= 1 && pn <= 4) {
            bf16_t* dst = (pn == 1) ? NAQ : (pn == 2) ? NAK : (pn == 3) ? U : V; const float sc = (pn == 1) ? 0.125f * LOG2E : 1.0f;
#pragma unroll
            for (int ai = 0; ai < 2; ++ai)
#pragma unroll
                for (int m = 0; m < 4; ++m) { bf16_t* rowp = dst + (size_t)(row0 + ai * 128 + m * 16) * 256 + wc * 32 + fq * 8;
#pragma unroll
                    for (int bj = 0; bj < 2; ++bj) *(u32x4*)(rowp + bj * 128) = pack8(acc[ai][bj][m][0] * sc, acc[ai][bj][m][1] * sc); }
            return;
        }
        if (pn == 0 || pn == 5) {
            bf16_t* dst = (pn == 0) ? CKV : CQ; const int ld = (pn == 0) ? 256 : 384; const int slot = (pn == 0) ? 0 : 4;
#pragma unroll
            for (int ai = 0; ai < 2; ++ai)
#pragma unroll
                for (int m = 0; m < 4; ++m) { const int r = row0 + ai * 128 + m * 16; bf16_t* rowp = dst + (size_t)r * ld + wc * 32 + fq * 8; float s = 0.f;
#pragma unroll
                    for (int bj = 0; bj < 2; ++bj) { const f32x4 a = acc[ai][bj][m][0], b = acc[ai][bj][m][1]; *(u32x4*)(rowp + bj * 128) = pack8(a, b);
                        s += (a[0] * a[0] + a[1] * a[1]) + (a[2] * a[2] + a[3] * a[3]) + (b[0] * b[0] + b[1] * b[1]) + (b[2] * b[2] + b[3] * b[3]); }
                    s += __shfl_xor(s, 16); s += __shfl_xor(s, 32);
                    if (fq == 0) SSQ[(size_t)r * 12 + slot + wc] = s; }
            return;
        }
#pragma unroll
        for (int ai = 0; ai < 2; ++ai)
#pragma unroll
            for (int m = 0; m < 4; ++m) { const int r = row0 + ai * 128 + m * 16;
                { const f32x4 a = acc[ai][0][m][0], b = acc[ai][0][m][1]; *(u32x4*)(CQ + (size_t)r * 384 + 256 + wc * 32 + fq * 8) = pack8(a, b);
                  float s = (a[0] * a[0] + a[1] * a[1]) + (a[2] * a[2] + a[3] * a[3]) + (b[0] * b[0] + b[1] * b[1]) + (b[2] * b[2] + b[3] * b[3]);
                  s += __shfl_xor(s, 16); s += __shfl_xor(s, 32);
                  if (fq == 0) SSQ[(size_t)r * 12 + 8 + wc] = s; }
                if (wc == 0) { f32x4 a = acc[ai][1][m][0], b = acc[ai][1][m][1]; int bb, pos; bool lat; row_b_pos(r, bb, pos, lat);
                    if (lat) rope8(a, b, fq, r & 4095, TAB);
                    const u32x4 w = pack8(a, b); bf16_t* kp = K + ((size_t)(bb * 8) * LK + pos) * 96 + 64 + fq * 8;
#pragma unroll
                    for (int h = 0; h < 8; ++h) *(u32x4*)(kp + (size_t)h * LK * 96) = w; } }
    }
};

struct EpiG2Q {
    bf16_t* Q; const float* SSQ; const float* TAB;
    __device__ __forceinline__ void operator()(const AccT& acc, const pg8::Unit& u, int wr, int wc, int fr, int fq) const {
        const int row0 = u.pm * 256 + wr * 64 + fr; const float QS = 0.10206207261596575f * LOG2E;
#pragma unroll
        for (int ai = 0; ai < 2; ++ai)
#pragma unroll
            for (int m = 0; m < 4; ++m) { const int r = row0 + ai * 128 + m * 16;
                const f32x4 s0 = *(const f32x4*)(SSQ + (size_t)r * 12 + 4), s1 = *(const f32x4*)(SSQ + (size_t)r * 12 + 8);
                const float ss = ((s0[0] + s0[1]) + (s0[2] + s0[3])) + ((s1[0] + s1[1]) + (s1[2] + s1[3]));
                const float sc = QS * __builtin_amdgcn_rsqf(ss * (1.0f / 384.0f) + EPS);
#pragma unroll
                for (int bj = 0; bj < 2; ++bj) { f32x4 a = acc[ai][bj][m][0] * sc, b = acc[ai][bj][m][1] * sc;
                    if (u.pn < 2) { const int c = u.pn * 256 + bj * 128 + wc * 32 + fq * 8; *(u32x4*)(Q + (size_t)r * 768 + (c >> 6) * 96 + (c & 63)) = pack8(a, b); }
                    else { if (r < MX) rope8(a, b, fq, r & 4095, TAB); *(u32x4*)(Q + (size_t)r * 768 + (bj * 4 + wc) * 96 + 64 + fq * 8) = pack8(a, b); } } asm volatile("" ::: "memory"); }
    }
};
struct SchedG2KV {
    const char* CKV; const char* W; int G, c;
    __device__ __forceinline__ bool next(int i, pg8::Unit& u) const {
        int L = i * G + c; u.nt = 4;
        if (L < 272) { int pm, pn; static_tile(L, 136, 2, pm, pn); u.A = CKV + (size_t)pm * 256 * 512; u.B = W + (size_t)pn * 256 * 512; u.job = 0; u.pm = pm; u.pn = pn; return true; }
        L -= 272;
        if (L < 272) { int pn, pm; static_tile(L, 136, 2, pn, pm); u.A = W + (size_t)(512 + pm * 256) * 512; u.B = CKV + (size_t)pn * 256 * 512; u.job = 1; u.pm = pm; u.pn = pn; return true; }
        return false;
    }
};
struct EpiG2KV {
    bf16_t *K, *VT; const float* SSQ;
    __device__ __forceinline__ void operator()(const AccT& acc, const pg8::Unit& u, int wr, int wc, int fr, int fq) const {
        if (u.job == 0) {
            const int row0 = u.pm * 256 + wr * 64 + fr;
#pragma unroll
            for (int ai = 0; ai < 2; ++ai)
#pragma unroll
                for (int m = 0; m < 4; ++m) { const int r = row0 + ai * 128 + m * 16; const f32x4 s0 = *(const f32x4*)(SSQ + (size_t)r * 12);
                    const float sc = __builtin_amdgcn_rsqf(((s0[0] + s0[1]) + (s0[2] + s0[3])) * (1.0f / 256.0f) + EPS);
                    int bb, pos; bool lat; row_b_pos(r, bb, pos, lat);
#pragma unroll
                    for (int bj = 0; bj < 2; ++bj) { const int c = u.pn * 256 + bj * 128 + wc * 32 + fq * 8;
                        *(u32x4*)(K + ((size_t)(bb * 8 + (c >> 6)) * LK + pos) * 96 + (c & 63)) = pack8(acc[ai][bj][m][0] * sc, acc[ai][bj][m][1] * sc); } asm volatile("" ::: "memory"); }
            return;
        }
        const int tn = u.pn; int b, pos0; if (tn < 128) { b = tn >> 4; pos0 = CTX + (tn & 15) * 256; } else { b = tn - 128; pos0 = 0; }
#pragma unroll
        for (int bj = 0; bj < 2; ++bj) { f32x4 sc0, sc1;
#pragma unroll
            for (int j = 0; j < 8; ++j) { const int t = tn * 256 + bj * 128 + wc * 32 + fq * 8 + j; const f32x4 s0 = *(const f32x4*)(SSQ + (size_t)t * 12);
                const float v = __builtin_amdgcn_rsqf(((s0[0] + s0[1]) + (s0[2] + s0[3])) * (1.0f / 256.0f) + EPS); if (j < 4) sc0[j & 3] = v; else sc1[j & 3] = v;
                if ((j & 3) == 3) asm volatile("" ::: "memory"); }
#pragma unroll
            for (int ai = 0; ai < 2; ++ai)
#pragma unroll
                for (int m = 0; m < 4; ++m) { const int f = u.pm * 256 + ai * 128 + wr * 64 + m * 16 + fr;
                    bf16_t* rowp = VT + ((size_t)(b * 512 + f) * LK + pos0) + wc * 32 + fq * 8;
                    *(u32x4*)(rowp + bj * 128) = pack8(acc[ai][bj][m][0] * sc0, acc[ai][bj][m][1] * sc1); }
            asm volatile("" ::: "memory"); }
    }
};

struct SchedG3 {
    const char* N; const char* Y; const char* WGL; const char* WBR; int nctx, G, c, f8g;
    __device__ __forceinline__ bool next(int i, pg8::Unit& u) const {
        const int nx = (512 - c + G - 1) / G;
        if (i >= 6 * nx) { const int j = i - 6 * nx, p = c + (j >> 1) * G; if (p >= nctx * 3) return false;
            const int T = p / 3, g = p - T * 3, pm = 128 + (T >> 2), pn = T & 3; u.pm = pm; u.pn = pn;
            if ((j & 1) == 0) { u.job = 8 + 2 * g; u.A = N + (size_t)pm * 256 * 2048; u.B = WGL + (size_t)(g * 1024 + pn * 256) * 2048; u.nt = f8g ? 8 : 16; u.f8 = f8g; }
            else { const int koff = (g == 0) ? 0 : (g == 1 ? 512 : 768); u.job = 8 + 2 * g + 1; u.A = Y + (size_t)pm * 256 * 2048 + koff * 2; u.B = WBR + (size_t)pn * 256 * 2048 + koff * 2; u.nt = (g == 0) ? 8 : 4; u.f8 = 0; }
            return true; }
        const int ti = i / 6, sub = i - ti * 6; const int L = ti * G + c;
        int pm, pn; static_tile(L, 128, 4, pm, pn); const int g = sub >> 1; u.job = sub; u.pm = pm; u.pn = pn;
        if ((sub & 1) == 0) { u.A = N + (size_t)pm * 256 * 2048; u.B = WGL + (size_t)(g * 1024 + pn * 256) * 2048; u.nt = f8g ? 8 : 16; u.f8 = f8g; }
        else { const int koff = (g == 0) ? 0 : (g == 1 ? 512 : 768); u.A = Y + (size_t)pm * 256 * 2048 + koff * 2; u.B = WBR + (size_t)pn * 256 * 2048 + koff * 2; u.nt = (g == 0) ? 8 : 4; u.f8 = 0; }
        return true;
    }
};
struct EpiG3 {
    bf16_t* Z; unsigned char* scr; bf16_t* ZP; float gsc;
    __device__ __forceinline__ void operator()(const AccT& acc, const pg8::Unit& u, int wr, int wc, int fr, int fq) const {
        const int sub = u.job & 7; const bool ctxp = (u.job & 8) != 0;
        const int tid_ = (wr * 4 + wc) * 64 + fq * 16 + fr; u32x4* gs = (u32x4*)scr + tid_; u32x4* zs = (u32x4*)(scr + 131072) + tid_;
        if ((sub & 1) == 0) {
#pragma unroll
            for (int ai = 0; ai < 2; ++ai)
#pragma unroll
                for (int bj = 0; bj < 2; ++bj)
#pragma unroll
                    for (int m = 0; m < 4; ++m) { f32x4 a = acc[ai][bj][m][0], b = acc[ai][bj][m][1];
#pragma unroll
                        for (int j = 0; j < 4; ++j) { a[j] = sigmoidf_(a[j] * gsc); b[j] = sigmoidf_(b[j] * gsc); }
                        gs[((ai * 2 + bj) * 4 + m) * 512] = pack8(a, b); asm volatile("" ::: "memory"); }
            return;
        }
#pragma unroll
        for (int ai = 0; ai < 2; ++ai)
#pragma unroll
            for (int mh = 0; mh < 2; ++mh) { u32x4 gq[4], zq[4];
#pragma unroll
                for (int q = 0; q < 4; ++q) { const int idx = ((ai * 2 + (q & 1)) * 4 + mh * 2 + (q >> 1)) * 512; gq[q] = gs[idx]; zq[q] = zs[idx]; }
#pragma unroll
                for (int q = 0; q < 4; ++q) { const int bj = q & 1, m = mh * 2 + (q >> 1), idx = ((ai * 2 + bj) * 4 + m) * 512; const u32x4 g = gq[q];
                    f32x4 a = acc[ai][bj][m][0], b = acc[ai][bj][m][1];
                    a[0] *= bf_lo(g.x); a[1] *= bf_hi(g.x); a[2] *= bf_lo(g.y); a[3] *= bf_hi(g.y); b[0] *= bf_lo(g.z); b[1] *= bf_hi(g.z); b[2] *= bf_lo(g.w); b[3] *= bf_hi(g.w);
                    if (sub > 1 && !ctxp) { const u32x4 z = zq[q]; a[0] += bf_lo(z.x); a[1] += bf_hi(z.x); a[2] += bf_lo(z.y); a[3] += bf_hi(z.y); b[0] += bf_lo(z.z); b[1] += bf_hi(z.z); b[2] += bf_lo(z.w); b[3] += bf_hi(z.w); }
                    const u32x4 w = pack8(a, b);
                    if (ctxp) *(u32x4*)(ZP + ((size_t)(sub >> 1) * MC + (u.pm - 128) * 256 + ai * 128 + wr * 64 + m * 16 + fr) * 1024 + u.pn * 256 + wc * 32 + fq * 8 + bj * 128) = w;
                    else if (sub == 5) *(u32x4*)(Z + (size_t)(u.pm * 256 + ai * 128 + wr * 64 + m * 16 + fr) * 1024 + u.pn * 256 + wc * 32 + fq * 8 + bj * 128) = w; else zs[idx] = w; }
                asm volatile("" ::: "memory"); }
    }
};

__device__ __forceinline__ float silu_mul(float g, float u) { return g * sigmoidf_(g) * u; }
struct EpiSwiglu {
    bf16_t* H; int ld; int pm_off;
    __device__ __forceinline__ void operator()(const AccT& acc, const pg8::Unit& u, int wr, int wc, int fr, int fq) const {
#pragma unroll
        for (int ai = 0; ai < 2; ++ai)
#pragma unroll
            for (int m = 0; m < 4; ++m) { bf16_t* rowp = H + (size_t)((u.pm - pm_off) * 256 + ai * 128 + wr * 64 + m * 16 + fr) * ld + u.pn * 128 + wc * 32 + fq * 8;
                f32x4 a, b;
                { const f32x4 g0 = acc[ai][0][m][0], g1 = acc[ai][0][m][1]; f32x4 e0 = g0 * (-LOG2E), e1 = g1 * (-LOG2E);
#pragma unroll
                  for (int j = 0; j < 4; ++j) { e0[j] = fast_exp2(e0[j]); e1[j] = fast_exp2(e1[j]); }
                  e0 = e0 + 1.0f; e1 = e1 + 1.0f;
#pragma unroll
                  for (int j = 0; j < 4; ++j) { e0[j] = __builtin_amdgcn_rcpf(e0[j]); e1[j] = __builtin_amdgcn_rcpf(e1[j]); }
                  a = (g0 * acc[ai][1][m][0]) * e0; b = (g1 * acc[ai][1][m][1]) * e1; }
                *(u32x4*)rowp = pack8(a, b); }
    }
};
struct EpiSwigluS {
    bf16_t* H; int ld; int pm_off;
    __device__ __forceinline__ void operator()(const AccT& acc, const pg8::Unit& u, int wr, int wc, int fr, int fq) const {
#pragma unroll
        for (int ai = 0; ai < 2; ++ai)
#pragma unroll
            for (int m = 0; m < 4; ++m) { bf16_t* rowp = H + (size_t)((u.pm - pm_off) * 256 + ai * 128 + wr * 64 + m * 16 + fr) * ld + u.pn * 128 + wc * 32 + fq * 8;
                f32x4 a, b;
                { const f32x4 g0 = acc[ai][0][m][0], g1 = acc[ai][0][m][1]; f32x4 e0 = g0 * (-LOG2E * 0.03125f) + 10.0f, e1 = g1 * (-LOG2E * 0.03125f) + 10.0f;
#pragma unroll
                  for (int j = 0; j < 4; ++j) { e0[j] = fast_exp2(e0[j]); e1[j] = fast_exp2(e1[j]); }
                  e0 = e0 + 1024.0f; e1 = e1 + 1024.0f;
#pragma unroll
                  for (int j = 0; j < 4; ++j) { e0[j] = __builtin_amdgcn_rcpf(e0[j]); e1[j] = __builtin_amdgcn_rcpf(e1[j]); }
                  a = (g0 * acc[ai][1][m][0]) * e0; b = (g1 * acc[ai][1][m][1]) * e1; }
                *(u32x4*)rowp = pack8(a, b); }
    }
};
struct EpiSwigluF8 {
    unsigned char* H; int ld; int pm_off;
    __device__ __forceinline__ void operator()(const AccT& acc, const pg8::Unit& u, int wr, int wc, int fr, int fq) const {
#pragma unroll
        for (int ai = 0; ai < 2; ++ai)
#pragma unroll
            for (int m = 0; m < 4; ++m) { unsigned char* rowp = H + (size_t)((u.pm - pm_off) * 256 + ai * 128 + wr * 64 + m * 16 + fr) * ld + u.pn * 128 + wc * 32 + fq * 8;
                f32x4 a, b;
                { const f32x4 g0 = acc[ai][0][m][0], g1 = acc[ai][0][m][1]; f32x4 e0 = g0 * (-LOG2E * 0.03125f) + 10.0f, e1 = g1 * (-LOG2E * 0.03125f) + 10.0f;
#pragma unroll
                  for (int j = 0; j < 4; ++j) { e0[j] = fast_exp2(e0[j]); e1[j] = fast_exp2(e1[j]); }
                  e0 = e0 + 1024.0f; e1 = e1 + 1024.0f;
#pragma unroll
                  for (int j = 0; j < 4; ++j) { e0[j] = __builtin_amdgcn_rcpf(e0[j]); e1[j] = __builtin_amdgcn_rcpf(e1[j]); }
                  a = (g0 * acc[ai][1][m][0]) * e0; b = (g1 * acc[ai][1][m][1]) * e1;
#pragma unroll
                  for (int j = 0; j < 4; ++j) { a[j] = __builtin_amdgcn_fmed3f(a[j], -440.0f, 440.0f); b[j] = __builtin_amdgcn_fmed3f(b[j], -440.0f, 440.0f); } }
                u32x2 w; w.x = (unsigned)pk4_fp8(a[0], a[1], a[2], a[3]); w.y = (unsigned)pk4_fp8(b[0], b[1], b[2], b[3]); *(u32x2*)rowp = w; }
    }
};
struct SchedMoeUp {
    const char* XG; const char* W; volatile LAS unsigned* MISC; int t_lo, t_hi, G, c; int tb[7];
    __device__ __forceinline__ bool next(int i, pg8::Unit& u) const {
        const int L = i * G + c; const int nM = t_hi - t_lo; if (L >= nM * 28) return false;
        int pm, pn; static_tile(L, nM, 28, pm, pn); const int gt = t_lo + pm; int e = 0;
#pragma unroll
        for (int j = 0; j < 7; ++j) e += (tb[j] <= gt) ? 1 : 0;
        u.A = XG + (size_t)gt * 256 * 1024; u.B = W + (size_t)(e * 7168 + pn * 256) * 1024; u.nt = 8; u.job = e; u.pm = gt; u.pn = pn; return true;
    }
};
struct SchedMoeDown {
    const char* HM; const char* W; volatile LAS unsigned* MISC; int t_lo, t_hi, G, c; int tb[7];
    __device__ __forceinline__ bool next(int i, pg8::Unit& u) const {
        const int L = i * G + c; const int nM = t_hi - t_lo; if (L >= nM * 4) return false;
        int pm, pn; static_tile(L, nM, 4, pm, pn); const int gt = t_lo + pm; int e = 0;
#pragma unroll
        for (int j = 0; j < 7; ++j) e += (tb[j] <= gt) ? 1 : 0;
        u.A = HM + (size_t)pm * 256 * 3584; u.B = W + (size_t)(e * 1024 + pn * 256) * 3584; u.nt = 28; u.job = e; u.pm = gt; u.pn = pn; return true;
    }
};
struct EpiMoeDown {
    bf16_t* Y2; const int* LTOK; const float* LW; volatile LAS unsigned* MISC;
    __device__ __forceinline__ void operator()(const AccT& acc, const pg8::Unit& u, int wr, int wc, int fr, int fq) const {
        const int e = u.job; const int pos0 = (u.pm - (int)MISC[MI_TB + e]) * 256 + wr * 64 + fr; const int cnt = (int)MISC[MI_CNT + e];
#pragma unroll
        for (int ai = 0; ai < 2; ++ai)
#pragma unroll
            for (int m = 0; m < 4; ++m) { const int pos = pos0 + ai * 128 + m * 16;
                if (pos < cnt) { const int tk = LTOK[e * 32768 + pos]; const float w = LW[e * 32768 + pos] * 0.015625f;
                    bf16_t* rowp = Y2 + (size_t)tk * 1024 + u.pn * 256 + wc * 32 + fq * 8;
#pragma unroll
                    for (int bj = 0; bj < 2; ++bj) *(u32x4*)(rowp + bj * 128) = pack8(acc[ai][bj][m][0] * w, acc[ai][bj][m][1] * w); } asm volatile("" ::: "memory"); }
    }
};

__device__ __forceinline__ void ld_f32(const float* p, int lane, f32x4 (&v)[4]) { const f32x4* q = (const f32x4*)p + lane;
#pragma unroll
    for (int j = 0; j < 4; ++j) v[j] = q[64 * j]; }
__device__ __forceinline__ void st_f32(float* p, int lane, const f32x4 (&v)[4]) { f32x4* q = (f32x4*)p + lane;
#pragma unroll
    for (int j = 0; j < 4; ++j) q[64 * j] = v[j]; }
__device__ __forceinline__ void ld_bf16(const bf16_t* p, int lane, f32x4 (&v)[4]) { const u32x2* q = (const u32x2*)p + lane;
#pragma unroll
    for (int j = 0; j < 4; ++j) { const u32x2 w = q[64 * j]; v[j] = (f32x4){bf_lo(w.x), bf_hi(w.x), bf_lo(w.y), bf_hi(w.y)}; } }
__device__ __forceinline__ void ld_raw(const bf16_t* p, int lane, u32x2 (&w)[4]) { const u32x2* q = (const u32x2*)p + lane;
#pragma unroll
    for (int j = 0; j < 4; ++j) w[j] = q[64 * j]; }
__device__ __forceinline__ void cvt_raw(const u32x2 (&w)[4], f32x4 (&v)[4]) {
#pragma unroll
    for (int j = 0; j < 4; ++j) v[j] = (f32x4){bf_lo(w[j].x), bf_hi(w[j].x), bf_lo(w[j].y), bf_hi(w[j].y)}; }
__device__ __forceinline__ void cp4(f32x4 (&d)[4], const f32x4 (&s)[4]) { d[0] = s[0]; d[1] = s[1]; d[2] = s[2]; d[3] = s[3]; }
__device__ __forceinline__ void cp4(u32x2 (&d)[4], const u32x2 (&s)[4]) { d[0] = s[0]; d[1] = s[1]; d[2] = s[2]; d[3] = s[3]; }
__device__ __forceinline__ void st_bf16(bf16_t* p, int lane, const f32x4 (&v)[4]) { u32x2* q = (u32x2*)p + lane;
#pragma unroll
    for (int j = 0; j < 4; ++j) { u32x2 w; w.x = pk2(v[j][0], v[j][1]); w.y = pk2(v[j][2], v[j][3]); q[64 * j] = w; } }
__device__ __forceinline__ float row_rstd(const f32x4 (&v)[4]) { float s = 0.f;
#pragma unroll
    for (int j = 0; j < 4; ++j) s += (v[j][0] * v[j][0] + v[j][1] * v[j][1]) + (v[j][2] * v[j][2] + v[j][3] * v[j][3]);
    return __builtin_amdgcn_rsqf(wave_sum(s) * (1.0f / 1024.0f) + EPS); }
__device__ __forceinline__ const float* modp(const Frame& F, int l, int v, int i) { return (const float*)(F.ctl + CW_MOD) + ((size_t)(l * 9 + v) * 6144 + i * 1024); }

__device__ __forceinline__ void make_affine(const Frame& F, const float* g, const float* mscale, const float* mshift, f32x4 (&A)[4], f32x4 (&B)[4]) {
    f32x4 gg[4], ms[4]; ld_f32(g, F.lane, gg); ld_f32(mscale, F.lane, ms); ld_f32(mshift, F.lane, B);
#pragma unroll
    for (int j = 0; j < 4; ++j) A[j] = gg[j] * (ms[j] + 1.0f);
}
__device__ __forceinline__ void make_gate(const Frame& F, const float* g, const float* mgate, f32x4 (&P)[4]) {
    f32x4 gg[4], mg[4]; ld_f32(g, F.lane, gg); ld_f32(mgate, F.lane, mg);
#pragma unroll
    for (int j = 0; j < 4; ++j) P[j] = gg[j] * mg[j];
}

__device__ __forceinline__ void st_n8(float* out, size_t row, int lane, const f32x4 (&v)[4]) {
    int* q = (int*)((unsigned char*)out + row * 2048) + lane;
#pragma unroll
    for (int j = 0; j < 4; ++j) q[64 * j] = pk4_fp8(clamp8(v[j][0]), clamp8(v[j][1]), clamp8(v[j][2]), clamp8(v[j][3])); }
__device__ __forceinline__ void phase_T0(const Frame& F) {
    const int gw = F.vcu * NWAVES + F.wave, NGW = F.G * NWAVES; bf16_t* N = wsb(F, WS_N);
    for (int ch = gw; ch < 2048; ch += NGW) { const int b = ch >> 8; f32x4 A[4], B[4]; make_affine(F, inp(F, IN_GPREMIX), modp(F, 0, b, 1), modp(F, 0, b, 0), A, B);
        const float* X = inp(F, IN_X); f32x4 hn[4]; ld_f32(X + (size_t)ch * 16 * 1024, F.lane, hn);
        for (int rr = 0; rr < 16; ++rr) { const size_t r = (size_t)ch * 16 + rr; f32x4 h[4]; cp4(h, hn); if (rr < 15) ld_f32(X + (r + 1) * 1024, F.lane, hn); const float rs = row_rstd(h);
#pragma unroll
            for (int j = 0; j < 4; ++j) h[j] = h[j] * rs * A[j] + B[j];
            st_bf16(N + r * 1024, F.lane, h); st_n8(F.out, r, F.lane, h); } }
    { f32x4 A[4], B[4]; make_affine(F, inp(F, IN_GPREMIX), modp(F, 0, 8, 1), modp(F, 0, 8, 0), A, B);
      for (int rc = gw; rc < MC; rc += NGW) { f32x4 h[4]; ld_f32(inp(F, IN_CTX) + (size_t)rc * 1024, F.lane, h); const float rs = row_rstd(h);
#pragma unroll
          for (int j = 0; j < 4; ++j) h[j] = h[j] * rs * A[j] + B[j];
          st_bf16(N + (size_t)(MX + rc) * 1024, F.lane, h); st_n8(F.out, (size_t)(MX + rc), F.lane, h); } }
}
template <bool MOE>
__device__ __forceinline__ void phase_T1(const Frame& F, int l) {
    const int gw = F.vcu * NWAVES + F.wave, NGW = F.G * NWAVES; bf16_t* N = wsb(F, WS_N); const bf16_t* O = wsb(F, WS_O);
    const float* gpost = inp(F, IN_GPOSTMIX) + l * 1024; const float* gpre = inp(F, IN_GPREFFN) + l * 1024;
    LAS float* WR = (LAS float*)F.lds;
    if (MOE) { const float* wr = inp(F, IN_WROUTER);
        for (int i = F.tid; i < 8192; i += NTHR) { const int d = i >> 3, e = i & 7; WR[e * 1024 + d] = wr[i]; }
        __syncthreads(); }
    for (int ch = gw; ch < 2048; ch += NGW) { const int b = ch >> 8; f32x4 P[4], A[4], B[4];
        make_gate(F, gpost, modp(F, l, b, 2), P); make_affine(F, gpre, modp(F, l, b, 4), modp(F, l, b, 3), A, B);
        int my_e = 0; float my_w = 0.f;
        bf16_t* HB = wsb(F, WS_HB); const float* X = inp(F, IN_X); u32x2 on[4]; f32x4 hn[4]; u32x2 hbn[4]; ld_raw(O + (size_t)ch * 16 * 1024, F.lane, on);
        if (MOE) ld_raw(HB + (size_t)ch * 16 * 1024, F.lane, hbn); else ld_f32(X + (size_t)ch * 16 * 1024, F.lane, hn);
        for (int rr = 0; rr < 16; ++rr) { const size_t r = (size_t)ch * 16 + rr; f32x4 o[4], h[4]; u32x2 oc[4], hbc[4];
            cp4(oc, on); if (MOE) cp4(hbc, hbn); else cp4(h, hn);
            if (rr < 15) { ld_raw(O + (r + 1) * 1024, F.lane, on); if (MOE) ld_raw(HB + (r + 1) * 1024, F.lane, hbn); else ld_f32(X + (r + 1) * 1024, F.lane, hn); }
            cvt_raw(oc, o); if (MOE) cvt_raw(hbc, h);
            const float ro = row_rstd(o);
#pragma unroll
            for (int j = 0; j < 4; ++j) h[j] = h[j] + P[j] * o[j] * ro;
            if (MOE) st_bf16(wsb(F, WS_HB1) + r * 1024, F.lane, h); else st_bf16(HB + r * 1024, F.lane, h);
            const float rh = row_rstd(h);
#pragma unroll
            for (int j = 0; j < 4; ++j) h[j] = h[j] * rh * A[j] + B[j];
            { int* n8 = (int*)((MOE ? F.ws + WS_N8M : (unsigned char*)N) + r * 1024) + F.lane;
#pragma unroll
                for (int j = 0; j < 4; ++j) n8[64 * j] = pk4_fp8(clamp8(h[j][0]), clamp8(h[j][1]), clamp8(h[j][2]), clamp8(h[j][3])); }
            if (MOE) {
                float lg[8];
#pragma unroll
                for (int e = 0; e < 8; ++e) { float s = 0.f;
#pragma unroll
                    for (int j = 0; j < 4; ++j) { const f32x4 w = *(const LAS f32x4*)(WR + e * 1024 + 4 * F.lane + 256 * j); s += (h[j][0] * w[0] + h[j][1] * w[1]) + (h[j][2] * w[2] + h[j][3] * w[3]); }
                    lg[e] = wave_sum(s); asm volatile("" ::: "memory"); }
                int i0 = 0; float l0 = lg[0];
#pragma unroll
                for (int e = 1; e < 8; ++e) if (lg[e] > l0) { l0 = lg[e]; i0 = e; }
                int i1 = -1; float l1 = -3.0e38f;
#pragma unroll
                for (int e = 0; e < 8; ++e) if (e != i0 && lg[e] > l1) { l1 = lg[e]; i1 = e; }
                const float ex = __expf(l1 - l0); const float w0 = 1.0f / (1.0f + ex), w1 = ex * w0;
                if (F.lane == 2 * rr) { my_e = i0; my_w = w0; }
                if (F.lane == 2 * rr + 1) { my_e = i1; my_w = w1; }
            }
        }
        if (MOE) {
            const bool act = F.lane < 32; unsigned rank = 0, mycnt = 0;
#pragma unroll
            for (int e = 0; e < 8; ++e) { const unsigned long long mk = __ballot(act && my_e == e); const unsigned c = (unsigned)__popcll(mk);
                if (my_e == e) rank = (unsigned)__popcll(mk & ((1ull << F.lane) - 1ull));
                if (F.lane == e) mycnt = c; }
            unsigned base = 0;
            if (F.lane < 8 && mycnt > 0) base = __hip_atomic_fetch_add(F.ctl + CW_CNT + 64 * F.lane, mycnt, __ATOMIC_RELAXED, __HIP_MEMORY_SCOPE_AGENT);
            const unsigned mybase = (unsigned)__shfl((int)base, my_e);
            if (act) { const unsigned pos = mybase + rank; const int tok = ch * 16 + (F.lane >> 1);
                ((int*)(F.ws + WS_LTOK))[my_e * 32768 + pos] = tok * 2 + (F.lane & 1); ((float*)(F.ws + WS_LW))[my_e * 32768 + pos] = my_w; }
        }
    }
    if (!MOE) {
        f32x4 P[4], A[4], B[4]; make_gate(F, gpost, modp(F, l, 8, 2), P); make_affine(F, gpre, modp(F, l, 8, 4), modp(F, l, 8, 3), A, B);
        float* HC = (float*)(F.ws + WS_HC);
        for (int rc = gw; rc < MC; rc += NGW) { f32x4 o[4], o1[4], o2[4], h[4]; const bf16_t* OP = wsb(F, WS_OP);
            ld_bf16(OP + (size_t)rc * 1024, F.lane, o); ld_bf16(OP + (size_t)(MC + rc) * 1024, F.lane, o1); ld_bf16(OP + (size_t)(2 * MC + rc) * 1024, F.lane, o2); ld_f32(inp(F, IN_CTX) + (size_t)rc * 1024, F.lane, h);
#pragma unroll
            for (int j = 0; j < 4; ++j) o[j] = o[j] + o1[j] + o2[j];
            const float ro = row_rstd(o);
#pragma unroll
            for (int j = 0; j < 4; ++j) h[j] = h[j] + P[j] * o[j] * ro;
            st_f32(HC + (size_t)rc * 1024, F.lane, h);
            const float rh = row_rstd(h);
#pragma unroll
            for (int j = 0; j < 4; ++j) h[j] = h[j] * rh * A[j] + B[j];
            { int* n8 = (int*)((unsigned char*)N + (size_t)(MX + rc) * 1024) + F.lane;
#pragma unroll
              for (int j = 0; j < 4; ++j) n8[64 * j] = pk4_fp8(clamp8(h[j][0]), clamp8(h[j][1]), clamp8(h[j][2]), clamp8(h[j][3])); } }
    }
}
template <bool MOE, bool LAST>
__device__ __forceinline__ void phase_T2(const Frame& F, int l) {
    const int gw = F.vcu * NWAVES + F.wave, NGW = F.G * NWAVES; bf16_t* N = wsb(F, WS_N); const bf16_t* Fb = wsb(F, WS_F); const bf16_t* Y2 = wsb(F, WS_Y2);
    const float* gpost = inp(F, IN_GPOSTFFN) + l * 1024;
    for (int ch = gw; ch < 2048; ch += NGW) { const int b = ch >> 8; f32x4 P[4], A[4], B[4];
        make_gate(F, gpost, modp(F, l, b, 5), P);
        if (!LAST) make_affine(F, inp(F, IN_GPREMIX) + (l + 1) * 1024, modp(F, l + 1, b, 1), modp(F, l + 1, b, 0), A, B);
        bf16_t* HB = wsb(F, WS_HB); const bf16_t* HR = MOE ? wsb(F, WS_HB1) : HB; u32x2 fn[4], gn[4], hn[4];
        { const size_t r0 = (size_t)ch * 16; if (MOE) { ld_raw(Y2 + r0 * 2048, F.lane, fn); ld_raw(Y2 + r0 * 2048 + 1024, F.lane, gn); } else ld_raw(Fb + r0 * 1024, F.lane, fn);
          ld_raw(HR + r0 * 1024, F.lane, hn); }
        for (int rr = 0; rr < 16; ++rr) { const size_t r = (size_t)ch * 16 + rr; f32x4 f[4], h[4]; u32x2 fc[4], gc[4], hc[4];
            cp4(fc, fn); if (MOE) cp4(gc, gn); cp4(hc, hn);
            if (rr < 15) { if (MOE) { ld_raw(Y2 + (r + 1) * 2048, F.lane, fn); ld_raw(Y2 + (r + 1) * 2048 + 1024, F.lane, gn); } else ld_raw(Fb + (r + 1) * 1024, F.lane, fn);
                ld_raw(HR + (r + 1) * 1024, F.lane, hn); }
            cvt_raw(fc, f); cvt_raw(hc, h);
            if (MOE) { f32x4 f2[4]; cvt_raw(gc, f2);
#pragma unroll
                for (int j = 0; j < 4; ++j) f[j] = f[j] + f2[j]; }
            const float rf = row_rstd(f);
#pragma unroll
            for (int j = 0; j < 4; ++j) h[j] = h[j] + P[j] * f[j] * rf;
            if (LAST) st_f32(F.out + r * 1024, F.lane, h); else st_bf16(HB + r * 1024, F.lane, h);
            if (!LAST) { const float rh = row_rstd(h);
#pragma unroll
                for (int j = 0; j < 4; ++j) h[j] = h[j] * rh * A[j] + B[j];
                st_bf16(N + r * 1024, F.lane, h); st_n8(F.out, r, F.lane, h); } } }
    if (!LAST) {
        f32x4 P[4], A[4], B[4]; make_gate(F, gpost, modp(F, l, 8, 5), P); make_affine(F, inp(F, IN_GPREMIX) + (l + 1) * 1024, modp(F, l + 1, 8, 1), modp(F, l + 1, 8, 0), A, B);
        float* HC = (float*)(F.ws + WS_HC);
        for (int rc = gw; rc < MC; rc += NGW) { f32x4 f[4], f1[4], h[4]; ld_bf16(Fb + (size_t)(MX + rc) * 1024, F.lane, f); ld_bf16(wsb(F, WS_FP) + (size_t)rc * 1024, F.lane, f1); ld_f32(HC + (size_t)rc * 1024, F.lane, h);
#pragma unroll
            for (int j = 0; j < 4; ++j) f[j] = f[j] + f1[j];
            const float rf = row_rstd(f);
#pragma unroll
            for (int j = 0; j < 4; ++j) h[j] = h[j] + P[j] * f[j] * rf;
            st_f32(HC + (size_t)rc * 1024, F.lane, h);
            const float rh = row_rstd(h);
#pragma unroll
            for (int j = 0; j < 4; ++j) h[j] = h[j] * rh * A[j] + B[j];
            st_bf16(N + (size_t)(MX + rc) * 1024, F.lane, h); }
    }
}

__device__ __forceinline__ void transpose_item(const float* W, int N, int k0, int n0, const float* gk, bf16_t* WT, int ldt, int drow0, LAS float* scr, int lane) {
    f32x4 v[8];
#pragma unroll
    for (int j = 0; j < 8; ++j) v[j] = *(const f32x4*)(W + (size_t)(k0 + j * 8 + (lane >> 3)) * N + n0 + 4 * (lane & 7));
#pragma unroll
    for (int j = 0; j < 8; ++j) { const int kk = j * 8 + (lane >> 3); f32x4 x = v[j]; if (gk) x = x * gk[k0 + kk];
        LAS float* d = scr + kk * 33 + 4 * (lane & 7); d[0] = x[0]; d[1] = x[1]; d[2] = x[2]; d[3] = x[3]; }
    LDS_WAIT(); asm volatile("" ::: "memory");
    const int c = lane & 7;
#pragma unroll
    for (int j = 0; j < 4; ++j) { const int n = (lane >> 3) + 8 * j; const LAS float* s = scr + (8 * c) * 33 + n;
        u32x4 o; o.x = pk2(s[0 * 33], s[1 * 33]); o.y = pk2(s[2 * 33], s[3 * 33]); o.z = pk2(s[4 * 33], s[5 * 33]); o.w = pk2(s[6 * 33], s[7 * 33]);
        *(u32x4*)(WT + (size_t)(drow0 + n) * ldt + k0 + 8 * c) = o; }
    LDS_WAIT(); asm volatile("" ::: "memory");
}
__device__ __forceinline__ void transpose_item_f8(const float* W, int N, int k0, int n0, float sc, unsigned char* WT8, int ldt, int drow0, LAS float* scr, int lane) {
    f32x4 v[8];
#pragma unroll
    for (int j = 0; j < 8; ++j) v[j] = *(const f32x4*)(W + (size_t)(k0 + j * 8 + (lane >> 3)) * N + n0 + 4 * (lane & 7));
#pragma unroll
    for (int j = 0; j < 8; ++j) { const int kk = j * 8 + (lane >> 3); const f32x4 x = v[j] * sc;
        LAS float* d = scr + kk * 33 + 4 * (lane & 7); d[0] = x[0]; d[1] = x[1]; d[2] = x[2]; d[3] = x[3]; }
    LDS_WAIT(); asm volatile("" ::: "memory");
    const int n = lane & 31;
#pragma unroll
    for (int i = 0; i < 2; ++i) { const int c = (lane >> 5) * 2 + i; const LAS float* p = scr + (16 * c) * 33 + n;
        u32x4 o; o.x = (unsigned)pk4_fp8(p[0], p[33], p[66], p[99]); o.y = (unsigned)pk4_fp8(p[132], p[165], p[198], p[231]);
        o.z = (unsigned)pk4_fp8(p[264], p[297], p[330], p[363]); o.w = (unsigned)pk4_fp8(p[396], p[429], p[462], p[495]);
        *(u32x4*)(WT8 + (size_t)(drow0 + n) * ldt + k0 + 16 * c) = o; }
    LDS_WAIT(); asm volatile("" ::: "memory");
}
__device__ __forceinline__ int map_in(int n0) {
    if (n0 < 384) return 1280 + n0;
    if (n0 < 640) return n0 - 384;
    if (n0 < 672) return 1664 + (n0 - 640);
    if (n0 < 928) return 256 + (n0 - 672);
    if (n0 < 1184) return 512 + (n0 - 928);
    if (n0 < 1440) return 1792 + (n0 - 1184);
    if (n0 < 1696) return 768 + (n0 - 1440);
    if (n0 < 1952) return 1024 + (n0 - 1696);
    return -(n0 - 1952) - 1;
}
__device__ __forceinline__ void p0_convert_small(const Frame& F, LAS float* scr) {
    const int gw = F.vcu * NWAVES + F.wave, NGW = F.G * NWAVES;
    constexpr int I_IN = 16 * 157, I_UQ = 6 * 24, I_UKV = 4 * 32, I_BR = 16 * 32, I_OUT = 16 * 32, I_L = I_IN + I_UQ + I_UKV + I_BR + I_OUT;
    constexpr int I_F1 = 16 * 88, I_F2 = 44 * 32, NIT = 2 * I_L + 2 * I_F1 + I_F2;
    for (int it = gw; it < NIT; it += NGW) {
        int r = it;
        if (r < 2 * I_L) { const int l = r / I_L; r -= l * I_L;
            if (r < I_IN) { const int kb = r / 157, nb = r % 157; const int mr = map_in(nb * 32);
                if (mr >= 0) transpose_item(inp(F, IN_WIN) + (size_t)l * 1024 * INW, INW, kb * 64, nb * 32, nullptr, layer_w(F, l, OFF_WIN), 1024, mr, scr, F.lane);
                else transpose_item_f8(inp(F, IN_WIN) + (size_t)l * 1024 * INW, INW, kb * 64, nb * 32, 32.0f, (unsigned char*)layer_w(F, l, OFF_WGL), 2048, -mr - 1, scr, F.lane);
                continue; } r -= I_IN;
            if (r < I_UQ) { const int kb = r / 24, nb = r % 24; const int n0 = nb * 32, h = n0 / 96, j = n0 % 96; const int dr = (j < 64) ? h * 64 + j : 512 + h * 32 + (j - 64);
                transpose_item(inp(F, IN_WUQ) + (size_t)l * 384 * 768, 768, kb * 64, n0, inp(F, IN_GQ) + l * 384, layer_w(F, l, OFF_WUQ), 384, dr, scr, F.lane); continue; } r -= I_UQ;
            if (r < I_UKV) { const int kb = r / 32, nb = r % 32; const int n0 = nb * 32, h = n0 / 128, j = n0 % 128; const int dr = (j < 64) ? h * 64 + j : 512 + h * 64 + (j - 64);
                transpose_item(inp(F, IN_WUKV) + (size_t)l * 256 * 1024, 1024, kb * 64, n0, inp(F, IN_GKV) + l * 256, layer_w(F, l, OFF_WUKV), 256, dr, scr, F.lane); continue; } r -= I_UKV;
            if (r < I_BR) { const int kb = r / 32, nb = r % 32; transpose_item(inp(F, IN_WBR) + (size_t)l * 1024 * 1024, 1024, kb * 64, nb * 32, nullptr, layer_w(F, l, OFF_WBR), 1024, nb * 32, scr, F.lane); continue; } r -= I_BR;
            { const int kb = r / 32, nb = r % 32; transpose_item(inp(F, IN_WOUT) + (size_t)l * 1024 * 1024, 1024, kb * 64, nb * 32, nullptr, layer_w(F, l, OFF_WOUT), 1024, nb * 32, scr, F.lane); continue; }
        }
        r -= 2 * I_L;
        if (r < 2 * I_F1) { const int which = r / I_F1; r -= which * I_F1; const int kb = r / 88, nb = r % 88, n0 = nb * 32;
            transpose_item_f8(inp(F, which ? IN_WFFN3 : IN_WFFN1), DFF, kb * 64, n0, 32.0f, (unsigned char*)wsb(F, WS_WF13), 1024, (n0 >> 7) * 256 + (n0 & 127) + which * 128, scr, F.lane); continue; }
        r -= 2 * I_F1;
        { const int kb = r / 32, nb = r % 32; transpose_item_f8(inp(F, IN_WFFN2), 1024, kb * 64, nb * 32, 64.0f, (unsigned char*)wsb(F, WS_WF2), DFF, nb * 32, scr, F.lane); }
    }
    for (int i = (F.vcu * NTHR + F.tid) * 4; i < 2 * 4 * 128 * 128; i += F.G * NTHR * 4) { const int l = i >> 16, o = i & 65535; const f32x4 v = *(const f32x4*)(inp(F, IN_WSP) + i);
        u32x2 w; w.x = pk2(v[0], v[1]); w.y = pk2(v[2], v[3]); *(u32x2*)(layer_w(F, l, OFF_WSP) + o) = w; }
}
__device__ __forceinline__ void p0_convert_moe(const Frame& F, LAS float* scr) {
    const int gw = F.vcu * NWAVES + F.wave, NGW = F.G * NWAVES;
    constexpr int I_13 = 16 * 112, I_2 = 56 * 32, I_E = 2 * I_13 + I_2;
    for (int it = gw; it < 8 * I_E; it += NGW) { const int e = it / I_E; int r = it - e * I_E;
        if (r < 2 * I_13) { const int which = r / I_13; r -= which * I_13; const int kb = r / 112, nb = r % 112, n0 = nb * 32;
            transpose_item_f8(inp(F, which ? IN_WMOE3 : IN_WMOE1) + (size_t)e * 1024 * DFE, DFE, kb * 64, n0, 32.0f, F.ws + WS_WM13 + (size_t)e * 7168 * 1024, 1024, (n0 >> 7) * 256 + (n0 & 127) + which * 128, scr, F.lane); continue; }
        r -= 2 * I_13;
        { const int kb = r / 32, nb = r % 32; transpose_item_f8(inp(F, IN_WMOE2) + (size_t)e * DFE * 1024, 1024, kb * 64, nb * 32, 64.0f, F.ws + WS_WM2 + (size_t)e * 1024 * DFE, DFE, nb * 32, scr, F.lane); }
    }
}
__device__ __forceinline__ void p0_mods(const Frame& F) {
    LAS float* sm = (LAS float*)(F.lds + 65536);
    LAS float* red = (LAS float*)(F.lds + 102400);
    float* MOD = (float*)(F.ctl + CW_MOD);
    const float* C = inp(F, IN_C); const float* CC = inp(F, IN_CCTX); const float* WM = inp(F, IN_WMOD); const float* BM = inp(F, IN_BMOD);
    __syncthreads();
    for (int i = F.tid; i < 9 * 1024; i += NTHR) { const int v = i >> 10, k = i & 1023; const float c = (v < 8) ? C[v * 1024 + k] : CC[k]; sm[i] = c / (1.0f + __expf(-c)); }
    __syncthreads();
    for (int it = F.vcu; it < 2 * 96; it += F.G) { const int l = it / 96, n = (it % 96) * 64 + F.lane; float acc[9];
#pragma unroll
        for (int v = 0; v < 9; ++v) acc[v] = 0.f;
        const float* w = WM + ((size_t)l * 1024 + F.wave * 128) * 6144 + n;
#pragma unroll 8
        for (int k = 0; k < 128; ++k) { const float wv = w[(size_t)k * 6144];
#pragma unroll
            for (int v = 0; v < 9; ++v) acc[v] += sm[v * 1024 + F.wave * 128 + k] * wv; }
#pragma unroll
        for (int v = 0; v < 9; ++v) red[(F.wave * 9 + v) * 64 + F.lane] = acc[v];
        __syncthreads();
        for (int i = F.tid; i < 9 * 64; i += NTHR) { const int v = i >> 6, c = i & 63; float s = BM[l * 6144 + (it % 96) * 64 + c];
#pragma unroll
            for (int w8 = 0; w8 < 8; ++w8) s += red[(w8 * 9 + v) * 64 + c];
            MOD[(size_t)(l * 9 + v) * 6144 + (it % 96) * 64 + c] = s; }
        __syncthreads();
    }
    if (F.vcu == 0) { float* TAB = (float*)(F.ws + WS_TAB); const int p = F.tid >> 3, j = F.tid & 7;
        const float inv = powf(10000.0f, -(float)j * 0.125f); const float ang = (float)p * inv; TAB[(p * 8 + j) * 2] = cosf(ang); TAB[(p * 8 + j) * 2 + 1] = sinf(ang); }
}

__device__ __forceinline__ f32x16 mfma32(bf16x8 a, bf16x8 b, f32x16 c) { return __builtin_amdgcn_mfma_f32_32x32x16_bf16(a, b, c, 0, 0, 0); }
__device__ __forceinline__ float max16(const f32x16& p) { float a = fmaxf(fmaxf(p[0], p[1]), fmaxf(p[2], p[3]));
#pragma unroll
    for (int r = 4; r < 16; r += 4) a = fmaxf(a, fmaxf(fmaxf(p[r], p[r + 1]), fmaxf(p[r + 2], p[r + 3])));
    return a; }
typedef float f32x2_t __attribute__((ext_vector_type(2))); typedef __bf16 bf16x2_t __attribute__((ext_vector_type(2)));
__device__ __forceinline__ unsigned cvtpk_s(float lo, float hi) { f32x2_t v = {lo, hi}; bf16x2_t b = __builtin_convertvector(v, bf16x2_t); return __builtin_bit_cast(unsigned, b); }
__device__ __forceinline__ bf16x8 pack_p(const f32x16& p, int s) { u32x4 w; w.x = cvtpk_s(p[8 * s + 0], p[8 * s + 1]); w.y = cvtpk_s(p[8 * s + 2], p[8 * s + 3]); w.z = cvtpk_s(p[8 * s + 4], p[8 * s + 5]); w.w = cvtpk_s(p[8 * s + 6], p[8 * s + 7]); return __builtin_bit_cast(bf16x8, w); }
__device__ __forceinline__ float softmax_tile(f32x16& s0, f32x16& s1, float& m_run, float& l_run) {
    float mx = fmaxf(max16(s0), max16(s1)); mx = fmaxf(mx, __shfl_xor(mx, 32));
    const float mnew = fmaxf(m_run, mx); const float alpha = fast_exp2(m_run - mnew); m_run = mnew; float ls = 0.f;
#pragma unroll
    for (int r = 0; r < 16; ++r) { s0[r] = fast_exp2(s0[r] - mnew); s1[r] = fast_exp2(s1[r] - mnew); ls += s0[r] + s1[r]; }
    l_run = l_run * alpha + ls; return alpha;
}
__device__ __forceinline__ void pv_tile(f32x16& o0, f32x16& o1, const f32x16& s0, const f32x16& s1, const LAS unsigned char* vrow) {
#pragma unroll
    for (int kb = 0; kb < 2; ++kb)
#pragma unroll
        for (int s = 0; s < 2; ++s) { const bf16x8 pb = pack_p(kb ? s1 : s0, s);
#pragma unroll
            for (int db = 0; db < 2; ++db) { const LAS unsigned char* vp = vrow + db * 32 * 136 + (kb * 32 + s * 16) * 2;
                const u32x2 lo = *(const LAS u32x2*)vp, hi2 = *(const LAS u32x2*)(vp + 16); u32x4 w; w.x = lo.x; w.y = lo.y; w.z = hi2.x; w.w = hi2.y;
                if (db == 0) o0 = mfma32(__builtin_bit_cast(bf16x8, w), pb, o0); else o1 = mfma32(__builtin_bit_cast(bf16x8, w), pb, o1); } }
}
constexpr float MLA_THR = 6.0f;
__device__ __forceinline__ float max3f_(float a, float b, float c) { return fmaxf(fmaxf(a, b), c); }
#define SBAR() __builtin_amdgcn_sched_barrier(0)
__device__ __forceinline__ void mla_unit(const Frame& F, int b, int h, const bf16_t* Qr0, bf16_t* Yr0, int NT) {
    const int tid = F.tid, lane = F.lane, r32 = lane & 31, hi = lane >> 5, wid = F.wave, half = wid >> 2;
    const bf16_t* Kh = wsb(F, WS_K) + (size_t)(b * 8 + h) * LK * 96; const bf16_t* Vh = wsb(F, WS_VT) + (size_t)(b * 8 + h) * 64 * LK;
    constexpr int KBYTES = 13312, BUFB = 13312 + 9216;
    LAS unsigned char* L = F.lds;
    bf16x8 qf[6];
#pragma unroll
    for (int t = 0; t < 6; ++t) qf[t] = *(const bf16x8*)(Qr0 + (size_t)(wid * 32 + r32) * 768 + t * 16 + hi * 8);
    const int c1 = tid + 512; const int kw0 = (tid / 12) * 208 + (tid % 12) * 16, kw1 = (c1 / 12) * 208 + (c1 % 12) * 16;
    const int vch = tid & 7; const int vw = KBYTES + (tid >> 3) * 144 + (vch >> 1) * 32 + (vch & 1) * 8;
    const bf16_t* kg = Kh + tid * 8; const bf16_t* vg = Vh + (size_t)(tid >> 3) * LK + vch * 8;
    const int kro = r32 * 208 + hi * 16, vro = KBYTES + r32 * 144 + hi * 16;
    u32x4 kr0, kr1 = (u32x4){0u, 0u, 0u, 0u}, vr;
#define MLA_GLOAD(t_) do { kr0 = *(const u32x4*)(kg + (size_t)(t_) * 6144); if (tid < 256) kr1 = *(const u32x4*)(kg + (size_t)(t_) * 6144 + 4096); vr = *(const u32x4*)(vg + (t_) * 64); } while (0)
#define MLA_LWRITE(bo_) do { *(LAS u32x4*)(L + (bo_) + kw0) = kr0; if (tid < 256) *(LAS u32x4*)(L + (bo_) + kw1) = kr1; \
        *(LAS u32x2*)(L + (bo_) + vw) = (u32x2){vr.x, vr.y}; *(LAS u32x2*)(L + (bo_) + vw + 16) = (u32x2){vr.z, vr.w}; } while (0)
#define MLA_QK(bo_) do { const LAS unsigned char* kb_ = L + (bo_) + kro; \
        { const bf16x8 a0 = *(const LAS bf16x8*)(kb_), a1 = *(const LAS bf16x8*)(kb_ + 32 * 208); s0 = mfma32(a0, qf[0], negm); s1 = mfma32(a1, qf[0], negm); } \
        _Pragma("unroll") for (int t6 = 1; t6 < 6; ++t6) { const bf16x8 a0 = *(const LAS bf16x8*)(kb_ + t6 * 32), a1 = *(const LAS bf16x8*)(kb_ + 32 * 208 + t6 * 32); s0 = mfma32(a0, qf[t6], s0); s1 = mfma32(a1, qf[t6], s1); } } while (0)
#define MLA_KLOAD(bo_) do { const LAS unsigned char* kb_ = L + (bo_) + kro; \
        _Pragma("unroll") for (int t6 = 0; t6 < 3; ++t6) { kf[2 * t6] = *(const LAS bf16x8*)(kb_ + t6 * 32); kf[2 * t6 + 1] = *(const LAS bf16x8*)(kb_ + 32 * 208 + t6 * 32); } } while (0)
#define MLA_QKR(bo_) do { const LAS unsigned char* kb_ = L + (bo_) + kro; \
        s0 = mfma32(kf[0], qf[0], negm); s1 = mfma32(kf[1], qf[0], negm); \
        _Pragma("unroll") for (int t6 = 1; t6 < 3; ++t6) { s0 = mfma32(kf[2 * t6], qf[t6], s0); s1 = mfma32(kf[2 * t6 + 1], qf[t6], s1); } \
        _Pragma("unroll") for (int t6 = 3; t6 < 6; ++t6) { const bf16x8 a0 = *(const LAS bf16x8*)(kb_ + t6 * 32), a1 = *(const LAS bf16x8*)(kb_ + 32 * 208 + t6 * 32); s0 = mfma32(a0, qf[t6], s0); s1 = mfma32(a1, qf[t6], s1); } } while (0)
#define MLA_PV(bo_) do { const LAS unsigned char* vrow_ = L + (bo_) + vro; \
        _Pragma("unroll") for (int g = 0; g < 4; ++g) { const bf16x8 v0 = *(const LAS bf16x8*)(vrow_ + g * 32), v1 = *(const LAS bf16x8*)(vrow_ + 32 * 144 + g * 32); o0 = mfma32(v0, pw[g], o0); o1 = mfma32(v1, pw[g], o1); } } while (0)
#define MLA_ROWMAX(mx_, a_, b_) do { mx_ = max3f_(a_[0], a_[1], b_[0]); _Pragma("unroll") for (int r = 2; r < 16; r += 2) mx_ = max3f_(mx_, a_[r], a_[r + 1]); \
        _Pragma("unroll") for (int r = 1; r < 15; r += 2) mx_ = max3f_(mx_, b_[r], b_[r + 1]); mx_ = fmaxf(mx_, b_[15]); \
        { auto rr = __builtin_amdgcn_permlane32_swap(__builtin_bit_cast(unsigned, mx_), __builtin_bit_cast(unsigned, mx_), false, false); \
          mx_ = fmaxf(__builtin_bit_cast(float, rr[0]), __builtin_bit_cast(float, rr[1])); } } while (0)
    MLA_GLOAD(0);
    __syncthreads();
    MLA_LWRITE(0);
    MLA_GLOAD(1);
    MLA_LWRITE(BUFB);
    __syncthreads();
    if (half == 1) __syncthreads();
    float m_ref = 0.f, l_run = 0.f, pend_f = 1.0f; bool pend = false; f32x16 o0 = {}, o1 = {}, negm = {};
    bf16x8 pw[4], kf[6];
    {
        f32x16 s0, s1;
        if (2 < NT) MLA_GLOAD(2);
        MLA_QK(0);
        __syncthreads();
        float mx; MLA_ROWMAX(mx, s0, s1); m_ref = mx; float ls = 0.f;
#pragma unroll
        for (int r = 0; r < 16; ++r) { negm[r] = -mx; s0[r] = fast_exp2(s0[r] - mx); s1[r] = fast_exp2(s1[r] - mx); ls += s0[r] + s1[r]; }
        l_run = ls; pw[0] = pack_p(s0, 0); pw[1] = pack_p(s0, 1); pw[2] = pack_p(s1, 0); pw[3] = pack_p(s1, 1);
        MLA_KLOAD(BUFB);
        if (2 < NT) MLA_LWRITE(2 * BUFB);
        __syncthreads();
    }
    int pb = 0, cb = BUFB, sb = 3 * BUFB;
    for (int t = 1; t < NT; ++t) {
        f32x16 s0, s1;
        if (t + 2 < NT) MLA_GLOAD(t + 2);
        {
            const LAS unsigned char* kb_ = L + cb + kro; const LAS unsigned char* vrow_ = L + pb + vro; bf16x8 kq[6], vf[8];
#pragma unroll
            for (int t6 = 3; t6 < 6; ++t6) { kq[2 * (t6 - 3)] = *(const LAS bf16x8*)(kb_ + t6 * 32); kq[2 * (t6 - 3) + 1] = *(const LAS bf16x8*)(kb_ + 32 * 208 + t6 * 32); }
#pragma unroll
            for (int g = 0; g < 2; ++g) { vf[2 * g] = *(const LAS bf16x8*)(vrow_ + g * 32); vf[2 * g + 1] = *(const LAS bf16x8*)(vrow_ + 32 * 144 + g * 32); }
            SBAR();
            s0 = mfma32(kf[0], qf[0], negm); s1 = mfma32(kf[1], qf[0], negm);
#pragma unroll
            for (int t6 = 1; t6 < 3; ++t6) { s0 = mfma32(kf[2 * t6], qf[t6], s0); s1 = mfma32(kf[2 * t6 + 1], qf[t6], s1); }
            SBAR();
#pragma unroll
            for (int g = 2; g < 4; ++g) { vf[2 * g] = *(const LAS bf16x8*)(vrow_ + g * 32); vf[2 * g + 1] = *(const LAS bf16x8*)(vrow_ + 32 * 144 + g * 32); }
            SBAR();
#pragma unroll
            for (int t6 = 3; t6 < 6; ++t6) { s0 = mfma32(kq[2 * (t6 - 3)], qf[t6], s0); s1 = mfma32(kq[2 * (t6 - 3) + 1], qf[t6], s1); }
#pragma unroll
            for (int g = 0; g < 4; ++g) { o0 = mfma32(vf[2 * g], pw[g], o0); o1 = mfma32(vf[2 * g + 1], pw[g], o1); }
        }
        asm volatile("" : "+v"(o0), "+v"(o1));
        SBAR();
        __syncthreads();
        float ls = 0.f;
#pragma unroll
        for (int r = 0; r < 16; ++r) { s0[r] = fast_exp2(s0[r]); s1[r] = fast_exp2(s1[r]); ls += s0[r] + s1[r]; }
        pw[0] = pack_p(s0, 0); pw[1] = pack_p(s0, 1); pw[2] = pack_p(s1, 0); pw[3] = pack_p(s1, 1);
        if (pend) {
            asm volatile("" ::: "memory");
#pragma unroll
            for (int r = 0; r < 16; ++r) { o0[r] *= pend_f; o1[r] *= pend_f; }
            l_run *= pend_f; }
        l_run += ls;
        float lv = ls; { auto rr = __builtin_amdgcn_permlane32_swap(__builtin_bit_cast(unsigned, lv), __builtin_bit_cast(unsigned, lv), false, false);
            lv = fmaxf(__builtin_bit_cast(float, rr[0]), __builtin_bit_cast(float, rr[1])); }
        pend = __any(lv > 4096.0f);
        if (pend) { asm volatile("" ::: "memory");
            const float dl = (lv > 2.0f) ? (float)((int)(__builtin_bit_cast(unsigned, lv) >> 23) - 127) : 0.f; m_ref += dl; pend_f = fast_exp2(-dl);
#pragma unroll
            for (int r = 0; r < 16; ++r) negm[r] = -m_ref; }
        if (t + 1 < NT) MLA_KLOAD((cb == 3 * BUFB) ? 0 : cb + BUFB);
        if (t + 2 < NT) MLA_LWRITE(sb);
        __syncthreads();
        pb = cb; cb = (cb == 3 * BUFB) ? 0 : cb + BUFB; sb = (sb == 3 * BUFB) ? 0 : sb + BUFB;
    }
    MLA_PV(pb);
    if (half == 0) __syncthreads();
#undef MLA_GLOAD
#undef MLA_LWRITE
#undef MLA_QK
#undef MLA_KLOAD
#undef MLA_QKR
#undef MLA_PV
#undef MLA_ROWMAX
    const float inv = 1.0f / (l_run + __shfl_xor(l_run, 32));
    bf16_t* yp = Yr0 + (size_t)(wid * 32 + r32) * 1024 + hi * 4;
#pragma unroll
    for (int g = 0; g < 4; ++g) { u32x2 w; w.x = pk2(o0[4 * g] * inv, o0[4 * g + 1] * inv); w.y = pk2(o0[4 * g + 2] * inv, o0[4 * g + 3] * inv); *(u32x2*)(yp + 8 * g) = w;
        w.x = pk2(o1[4 * g] * inv, o1[4 * g + 1] * inv); w.y = pk2(o1[4 * g + 2] * inv, o1[4 * g + 3] * inv); *(u32x2*)(yp + 32 + 8 * g) = w; }
}
__device__ __forceinline__ void mla_unit2(const Frame& F, int b, int h, const bf16_t* Qr0, bf16_t* Yr0, int NT) {
    int lane = F.lane; asm volatile("" : "+v"(lane));
    const int wid = F.wave, tid = wid * 64 + lane, r32 = lane & 31, hi = lane >> 5, half = wid >> 2;
    const bf16_t* Kh = wsb(F, WS_K) + (size_t)(b * 8 + h) * LK * 96; const bf16_t* Vh = wsb(F, WS_VT) + (size_t)(b * 8 + h) * 64 * LK;
    constexpr int KBYTES = 13312, BUFB = 13312 + 9216;
    LAS unsigned char* L = F.lds;
    bf16x8 qf[2][6];
#pragma unroll
    for (int q = 0; q < 2; ++q)
#pragma unroll
        for (int t = 0; t < 6; ++t) qf[q][t] = *(const bf16x8*)(Qr0 + (size_t)(wid * 64 + q * 32 + r32) * 768 + t * 16 + hi * 8);
    const int c1 = tid + 512; const int kw0 = (tid / 12) * 208 + (tid % 12) * 16, kw1 = (c1 / 12) * 208 + (c1 % 12) * 16;
    const int vch = tid & 7; const int vw = KBYTES + (tid >> 3) * 144 + (vch >> 1) * 32 + (vch & 1) * 8;
    const bf16_t* kg = Kh + tid * 8; const bf16_t* vg = Vh + (size_t)(tid >> 3) * LK + vch * 8;
    const int kro = r32 * 208 + hi * 16, vro = KBYTES + r32 * 144 + hi * 16;
    u32x4 kr0, kr1, vr;
#define M2_GLOAD(t_) do { kr0 = *(const u32x4*)(kg + (size_t)(t_) * 6144); vr = *(const u32x4*)(vg + (t_) * 64); } while (0)
#define M2_GLOAD1(t_) do { kr1 = *(const u32x4*)(kg + (size_t)(t_) * 6144 + 4096); } while (0)
#define M2_LWRITE(bo_) do { *(LAS u32x4*)(L + (bo_) + kw0) = kr0; if (tid < 256) *(LAS u32x4*)(L + (bo_) + kw1) = kr1; \
        *(LAS u32x2*)(L + (bo_) + vw) = (u32x2){vr.x, vr.y}; *(LAS u32x2*)(L + (bo_) + vw + 16) = (u32x2){vr.z, vr.w}; } while (0)
#define M2_QK(bo_) do { const LAS unsigned char* kb_ = L + (bo_) + kro; \
        _Pragma("unroll") for (int t6 = 0; t6 < 6; ++t6) { const bf16x8 a0 = *(const LAS bf16x8*)(kb_ + t6 * 32), a1 = *(const LAS bf16x8*)(kb_ + 32 * 208 + t6 * 32); \
            s[0][0] = mfma32(a0, qf[0][t6], s[0][0]); s[1][0] = mfma32(a0, qf[1][t6], s[1][0]); s[0][1] = mfma32(a1, qf[0][t6], s[0][1]); s[1][1] = mfma32(a1, qf[1][t6], s[1][1]); } } while (0)
#define M2_PV(bo_) do { const LAS unsigned char* vrow_ = L + (bo_) + vro; \
        _Pragma("unroll") for (int g = 0; g < 4; ++g) { const bf16x8 v0 = *(const LAS bf16x8*)(vrow_ + g * 32), v1 = *(const LAS bf16x8*)(vrow_ + 32 * 144 + g * 32); \
            o[0][0] = mfma32(v0, pw[0][g], o[0][0]); o[1][0] = mfma32(v0, pw[1][g], o[1][0]); o[0][1] = mfma32(v1, pw[0][g], o[0][1]); o[1][1] = mfma32(v1, pw[1][g], o[1][1]); } } while (0)
    auto swapmax = [&](float v) { auto rr = __builtin_amdgcn_permlane32_swap(__builtin_bit_cast(unsigned, v), __builtin_bit_cast(unsigned, v), false, false);
        return fmaxf(__builtin_bit_cast(float, rr[0]), __builtin_bit_cast(float, rr[1])); };
    M2_GLOAD(0); M2_GLOAD1(0);
    __syncthreads();
    M2_LWRITE(0);
    M2_GLOAD(1); M2_GLOAD1(1);
    M2_LWRITE(BUFB);
    __syncthreads();
    if (half == 1) __syncthreads();
    float m[2] = {0.f, 0.f}, l[2] = {0.f, 0.f}, pf[2] = {1.f, 1.f}; bool pend[2] = {false, false};
    f32x16 o[2][2] = {}; bf16x8 pw[2][4], fr[3];
#define M2_FPRE(bo_) do { const LAS unsigned char* kp_ = L + (bo_) + kro; fr[0] = *(const LAS bf16x8*)(kp_); fr[1] = *(const LAS bf16x8*)(kp_ + 32 * 208); fr[2] = *(const LAS bf16x8*)(kp_ + 32); } while (0)
    {
        f32x16 s[2][2] = {};
        M2_QK(0);
        __syncthreads();
        if (2 < NT) { M2_GLOAD(2); M2_GLOAD1(2); }
        SBAR();
#pragma unroll
        for (int q = 0; q < 2; ++q) { const float mx = swapmax(fmaxf(max16(s[q][0]), max16(s[q][1]))); m[q] = mx; float ls = 0.f;
#pragma unroll
            for (int r = 0; r < 16; ++r) { s[q][0][r] = fast_exp2(s[q][0][r] - mx); s[q][1][r] = fast_exp2(s[q][1][r] - mx); ls += s[q][0][r] + s[q][1][r]; }
            l[q] = ls; pw[q][0] = pack_p(s[q][0], 0); pw[q][1] = pack_p(s[q][0], 1); pw[q][2] = pack_p(s[q][1], 0); pw[q][3] = pack_p(s[q][1], 1); }
        if (2 < NT) M2_LWRITE(2 * BUFB);
        M2_FPRE(BUFB);
        __syncthreads();
    }
    int pb = 0, cb = BUFB, sb = 3 * BUFB;
    for (int t = 1; t < NT; ++t) {
        f32x16 s[2][2] = {};
        {
            const LAS unsigned char* kb_ = L + cb + kro; const LAS unsigned char* vrow_ = L + pb + vro;
#define M2_FADDR(i_) (((i_) < 12) ? kb_ + ((i_) >> 1) * 32 + ((i_) & 1) * 32 * 208 : vrow_ + (((i_) - 12) >> 1) * 32 + ((i_) & 1) * 32 * 144)
#pragma unroll
            for (int i = 0; i < 20; ++i) { const bf16x8 f = fr[i % 3];
                SBAR();
                if (i < 12) { s[0][i & 1] = mfma32(f, qf[0][i >> 1], s[0][i & 1]); s[1][i & 1] = mfma32(f, qf[1][i >> 1], s[1][i & 1]); }
                else { o[0][i & 1] = mfma32(f, pw[0][(i - 12) >> 1], o[0][i & 1]); o[1][i & 1] = mfma32(f, pw[1][(i - 12) >> 1], o[1][i & 1]); }
                SBAR();
                if (i + 3 < 20) fr[i % 3] = *(const LAS bf16x8*)M2_FADDR(i + 3); }
#undef M2_FADDR
        }
        asm volatile("" : "+v"(o[0][0]), "+v"(o[0][1]), "+v"(o[1][0]), "+v"(o[1][1]));
        SBAR();
        __syncthreads();
        if (t + 2 < NT) M2_GLOAD(t + 2);
        SBAR();
#pragma unroll
        for (int q = 0; q < 2; ++q) { const float mq = m[q]; float ls = 0.f;
#pragma unroll
            for (int r = 0; r < 16; ++r) { s[q][0][r] = fast_exp2(s[q][0][r] - mq); s[q][1][r] = fast_exp2(s[q][1][r] - mq); ls += s[q][0][r] + s[q][1][r]; }
            pw[q][0] = pack_p(s[q][0], 0); pw[q][1] = pack_p(s[q][0], 1); pw[q][2] = pack_p(s[q][1], 0); pw[q][3] = pack_p(s[q][1], 1);
            if (q == 0) { SBAR(); if (t + 2 < NT) M2_GLOAD1(t + 2); SBAR(); }
            if (pend[q]) { asm volatile("" ::: "memory");
#pragma unroll
                for (int r = 0; r < 16; ++r) { o[q][0][r] *= pf[q]; o[q][1][r] *= pf[q]; }
                l[q] *= pf[q]; }
            l[q] += ls;
            const float lv = swapmax(ls);
            pend[q] = __any(lv > 4096.0f);
            if (pend[q]) { asm volatile("" ::: "memory"); const float dl = (lv > 2.0f) ? (float)((int)(__builtin_bit_cast(unsigned, lv) >> 23) - 127) : 0.f; m[q] += dl; pf[q] = fast_exp2(-dl); } }
        if (t + 2 < NT) M2_LWRITE(sb);
        if (t + 1 < NT) M2_FPRE((cb == 3 * BUFB) ? 0 : cb + BUFB);
        __syncthreads();
        pb = cb; cb = (cb == 3 * BUFB) ? 0 : cb + BUFB; sb = (sb == 3 * BUFB) ? 0 : sb + BUFB;
    }
    M2_PV(pb);
    if (half == 0) __syncthreads();
#undef M2_GLOAD
#undef M2_FPRE
#undef M2_GLOAD1
#undef M2_LWRITE
#undef M2_QK
#undef M2_PV
    int le = F.lane; asm volatile("" : "+v"(le));
#pragma unroll
    for (int q = 0; q < 2; ++q) { const float inv = 1.0f / (l[q] + __builtin_bit_cast(float, __builtin_amdgcn_ds_bpermute((le ^ 32) << 2, __builtin_bit_cast(int, l[q]))));
        bf16_t* yp = Yr0 + (size_t)(wid * 64 + q * 32 + (le & 31)) * 1024 + (le >> 5) * 4;
#pragma unroll
        for (int g = 0; g < 4; ++g) { u32x2 w; w.x = pk2(o[q][0][4 * g] * inv, o[q][0][4 * g + 1] * inv); w.y = pk2(o[q][0][4 * g + 2] * inv, o[q][0][4 * g + 3] * inv); *(u32x2*)(yp + 8 * g) = w;
            w.x = pk2(o[q][1][4 * g] * inv, o[q][1][4 * g + 1] * inv); w.y = pk2(o[q][1][4 * g + 2] * inv, o[q][1][4 * g + 3] * inv); *(u32x2*)(yp + 32 + 8 * g) = w; } }
}
__device__ __forceinline__ void phase_mla(const Frame& F, bool with_ctx) {
    const bf16_t* Q = wsb(F, WS_Q); bf16_t* Y = wsb(F, WS_Y);
    for (int u = F.vcu; u < 512; u += F.G) { const int bh = u >> 3, qb = u & 7, b = bh >> 3, h = bh & 7; const size_t row0 = (size_t)b * 4096 + qb * 512;
        mla_unit2(F, b, h, Q + row0 * 768 + h * 96, Y + row0 * 1024 + h * 64, LK / 64); }
    if (with_ctx) for (int u = F.vcu; u < 64; u += F.G) { const int b = u >> 3, h = u & 7; const size_t row0 = (size_t)MX + b * 256;
        mla_unit(F, b, h, Q + row0 * 768 + h * 96, Y + row0 * 1024 + h * 64, CTX / 64); }
}

constexpr int NA_BUF = 68608, NA_RP = 137216 + 128;
template <int QH>
__device__ __forceinline__ void na_unit(const Frame& F, int b, int qrow0, bool latent, int grow) {
    int lane = F.lane; asm volatile("" : "+v"(lane));
    const int wid = F.wave, tid = wid * 64 + lane, r32 = lane & 31, hi = lane >> 5, h = wid >> 1, qc = QH * 32 + r32;
    const bf16_t* NAQ = wsb(F, WS_NAQ); const bf16_t* NAK = wsb(F, WS_NAK); const bf16_t* NAVT = wsb(F, WS_NAVT) + (size_t)b * 256 * LK; bf16_t* Y = wsb(F, WS_Y);
    LAS unsigned char* L = F.lds;
    const LAS float* RP = (const LAS float*)(L + NA_RP);
    bf16x8 qf[4];
#pragma unroll
    for (int t = 0; t < 4; ++t) qf[t] = *(const bf16x8*)(NAQ + (size_t)(qrow0 + qc) * 256 + h * 64 + t * 16 + hi * 8);
    const int rs = latent ? (grow < 4 ? 0 : (grow > 60 ? 56 : grow - 4)) : 0;
    const int ws_ = qc < 8 ? 0 : (qc > 56 ? 48 : qc - 8);
    float m_ref = 0.f, l_run = 0.f; f32x16 o0 = {}, o1 = {}, negm, cwm;
    unsigned mbits = 0u; float pm[4];
#pragma unroll
    for (int r = 0; r < 16; ++r) { const int kcm = (r & 3) + 8 * (r >> 2) + 4 * hi + 32 * QH; mbits |= ((unsigned)(kcm - ws_) < 16u) ? (1u << r) : 0u; }
#pragma unroll
    for (int r = 0; r < 4; ++r) { const int kcp = r + 4 * hi + (QH == 0 ? 32 : 24); pm[r] = ((unsigned)(kcp - ws_) < 16u) ? 0.f : -1.0e30f; }
    u32x4 kr[4], vr[4];
    const int t0 = latent ? 0 : 8;
    auto issue = [&](int t) {
        const unsigned char* kg = (const unsigned char*)((t < 8) ? NAK + ((size_t)b * 4096 + (rs + t) * 64) * 256 : NAK + ((size_t)MX + b * 256 + (t - 8) * 64) * 256);
        const unsigned char* vg = (const unsigned char*)(NAVT + ((t < 8) ? CTX + (rs + t) * 64 : (t - 8) * 64));
#pragma unroll
        for (int i = 0; i < 4; ++i) { kr[i] = *(const u32x4*)(kg + (unsigned)(tid * 16 + i * 8192)); vr[i] = *(const u32x4*)(vg + (unsigned)(((tid >> 3) + 64 * i) * (LK * 2) + (tid & 7) * 16)); }
    };
    auto lwrite = [&](int bo) {
#pragma unroll
        for (int i = 0; i < 4; ++i) { const int c = tid + 512 * i; *(LAS u32x4*)(L + bo + (c >> 5) * 528 + (c & 31) * 16) = kr[i];
            LAS unsigned char* vp = L + bo + 33792 + (c >> 3) * 136 + (c & 7) * 16; *(LAS u32x2*)vp = (u32x2){vr[i].x, vr[i].y}; *(LAS u32x2*)(vp + 8) = (u32x2){vr[i].z, vr[i].w}; }
    };
    auto set_c = [&]() {
        unsigned mb = mbits; asm volatile("" : "+v"(mb));
#pragma unroll
        for (int r = 0; r < 16; ++r) { negm[r] = -m_ref; cwm[r] = ((mb >> r) & 1u) ? -m_ref : -1.0e30f; }
    };
    auto swapmax = [&](float v) { auto rr = __builtin_amdgcn_permlane32_swap(__builtin_bit_cast(unsigned, v), __builtin_bit_cast(unsigned, v), false, false);
        return fmaxf(__builtin_bit_cast(float, rr[0]), __builtin_bit_cast(float, rr[1])); };
    auto guard = [&](float ls) {
        const float lv = swapmax(ls);
        if (__any(lv > 4096.0f)) { asm volatile("" ::: "memory");
            const float dl = (lv > 2.0f) ? (float)((int)(__builtin_bit_cast(unsigned, lv) >> 23) - 127) : 0.f; m_ref += dl; const float f = fast_exp2(-dl);
#pragma unroll
            for (int r = 0; r < 16; ++r) { o0[r] *= f; o1[r] *= f; }
            l_run *= f; set_c(); }
    };
#define NA_VMMA(kb_, s_, pb_) do { _Pragma("unroll") for (int db = 0; db < 2; ++db) { const LAS unsigned char* vp = vrow + db * 32 * 136 + ((kb_) * 32 + (s_) * 16) * 2; \
            const u32x2 lo = *(const LAS u32x2*)vp, hi2 = *(const LAS u32x2*)(vp + 16); u32x4 w; w.x = lo.x; w.y = lo.y; w.z = hi2.x; w.w = hi2.y; \
            if (db == 0) o0 = mfma32(__builtin_bit_cast(bf16x8, w), pb_, o0); else o1 = mfma32(__builtin_bit_cast(bf16x8, w), pb_, o1); } } while (0)
    set_c();
    issue(t0);
    __syncthreads();
    lwrite((t0 & 1) * NA_BUF);
    issue(t0 + 1);
    __syncthreads();
    if (latent) for (int t = 0; t < 8; ++t) {
        const int bo = (t & 1) * NA_BUF;
        lwrite(NA_BUF - bo); issue(t + 2);
        const LAS unsigned char* kb = L + bo + r32 * 528 + h * 128 + hi * 16;
        f32x16 s0, s1;
        { const bf16x8 a0 = *(const LAS bf16x8*)(kb), a1 = *(const LAS bf16x8*)(kb + 32 * 528); s0 = mfma32(a0, qf[0], QH == 0 ? cwm : negm); s1 = mfma32(a1, qf[0], QH == 0 ? negm : cwm); }
#pragma unroll
        for (int t4 = 1; t4 < 4; ++t4) { const bf16x8 a0 = *(const LAS bf16x8*)(kb + t4 * 32), a1 = *(const LAS bf16x8*)(kb + 32 * 528 + t4 * 32); s0 = mfma32(a0, qf[t4], s0); s1 = mfma32(a1, qf[t4], s1); }
        const LAS float* rp = RP + (h * 15 + (rs + t - grow + 7)) * 31 + (15 - qc);
#pragma unroll
        for (int r = 0; r < 16; ++r) { const int kc0 = (r & 3) + 8 * (r >> 2) + 4 * hi, kc1 = kc0 + 32;
            if (QH == 0) { s0[r] += rp[kc0]; if (r < 4) s1[r] += rp[kc1] + pm[r]; }
            else { s1[r] += rp[kc1]; if (r >= 12) s0[r] += rp[kc0] + pm[r - 12]; } }
        if (t == 0) { float mx = -1.0e30f;
#pragma unroll
            for (int r = 0; r < 16; ++r) { if (QH == 0 || r >= 12) mx = fmaxf(mx, s0[r]); if (QH == 1 || r < 4) mx = fmaxf(mx, s1[r]); }
            mx = swapmax(mx); m_ref = mx;
#pragma unroll
            for (int r = 0; r < 16; ++r) { s0[r] -= mx; s1[r] -= mx; } }
        float ls = 0.f;
#pragma unroll
        for (int r = 0; r < 16; ++r) { if (QH == 0 || r >= 12) { s0[r] = fast_exp2(s0[r]); ls += s0[r]; } else s0[r] = 0.f;
            if (QH == 1 || r < 4) { s1[r] = fast_exp2(s1[r]); ls += s1[r]; } else s1[r] = 0.f; }
        l_run += ls;
        const LAS unsigned char* vrow = L + bo + 33792 + (h * 64 + r32) * 136 + hi * 8;
        if (QH == 0) { NA_VMMA(0, 0, pack_p(s0, 0)); NA_VMMA(0, 1, pack_p(s0, 1)); NA_VMMA(1, 0, pack_p(s1, 0)); }
        else { NA_VMMA(0, 1, pack_p(s0, 1)); NA_VMMA(1, 0, pack_p(s1, 0)); NA_VMMA(1, 1, pack_p(s1, 1)); }
        if (t == 0) set_c(); else guard(ls);
        __syncthreads();
    }
    for (int t = 8; t < 12; ++t) {
        const int bo = (t & 1) * NA_BUF;
        if (t + 1 < 12) lwrite(NA_BUF - bo);
        if (t + 2 < 12) issue(t + 2);
        const LAS unsigned char* kb = L + bo + r32 * 528 + h * 128 + hi * 16;
        f32x16 s0, s1;
        { const bf16x8 a0 = *(const LAS bf16x8*)(kb), a1 = *(const LAS bf16x8*)(kb + 32 * 528); s0 = mfma32(a0, qf[0], negm); s1 = mfma32(a1, qf[0], negm); }
#pragma unroll
        for (int t4 = 1; t4 < 4; ++t4) { const bf16x8 a0 = *(const LAS bf16x8*)(kb + t4 * 32), a1 = *(const LAS bf16x8*)(kb + 32 * 528 + t4 * 32); s0 = mfma32(a0, qf[t4], s0); s1 = mfma32(a1, qf[t4], s1); }
        const bool first = !latent && t == 8;
        if (first) { float mx = swapmax(fmaxf(max16(s0), max16(s1))); m_ref = mx;
#pragma unroll
            for (int r = 0; r < 16; ++r) { s0[r] -= mx; s1[r] -= mx; } }
        float ls = 0.f;
#pragma unroll
        for (int r = 0; r < 16; ++r) { s0[r] = fast_exp2(s0[r]); s1[r] = fast_exp2(s1[r]); ls += s0[r] + s1[r]; }
        l_run += ls;
        const LAS unsigned char* vrow = L + bo + 33792 + (h * 64 + r32) * 136 + hi * 8;
        NA_VMMA(0, 0, pack_p(s0, 0)); NA_VMMA(0, 1, pack_p(s0, 1)); NA_VMMA(1, 0, pack_p(s1, 0)); NA_VMMA(1, 1, pack_p(s1, 1));
        if (first) set_c(); else guard(ls);
        __syncthreads();
    }
#undef NA_VMMA
    int le = F.lane; asm volatile("" : "+v"(le));
    const float inv = 1.0f / (l_run + __builtin_bit_cast(float, __builtin_amdgcn_ds_bpermute((le ^ 32) << 2, __builtin_bit_cast(int, l_run))));
    bf16_t* yp = Y + (size_t)(qrow0 + QH * 32 + (le & 31)) * 1024 + 512 + h * 64 + (le >> 5) * 4;
#pragma unroll
    for (int g = 0; g < 4; ++g) { u32x2 w; w.x = pk2(o0[4 * g] * inv, o0[4 * g + 1] * inv); w.y = pk2(o0[4 * g + 2] * inv, o0[4 * g + 3] * inv); *(u32x2*)(yp + 8 * g) = w;
        w.x = pk2(o1[4 * g] * inv, o1[4 * g + 1] * inv); w.y = pk2(o1[4 * g + 2] * inv, o1[4 * g + 3] * inv); *(u32x2*)(yp + 32 + 8 * g) = w; }
}
__device__ __forceinline__ void phase_na(const Frame& F, int l, bool with_ctx) {
    LAS float* RP = (LAS float*)(F.lds + NA_RP);
    __syncthreads();
    for (int i = F.tid; i < 4 * 15 * 31; i += NTHR) RP[i] = inp(F, IN_RPB)[l * 1860 + i] * LOG2E;
    if (F.tid < 32) { RP[F.tid - 32] = 0.f; RP[1860 + F.tid] = 0.f; }
    __syncthreads();
    const int nx = (F.vcu < 512) ? (512 - F.vcu + F.G - 1) / F.G : 0, cu0 = F.G - 1 - F.vcu;
    const int nc = (with_ctx && cu0 < 32) ? (32 - cu0 + F.G - 1) / F.G : 0;
    for (int k = 0; k < nx + nc; ++k) { const bool lat = k < nx; const int u = lat ? F.vcu + k * F.G : cu0 + (k - nx) * F.G;
        const int b = lat ? (u >> 6) : (u >> 2), q0 = lat ? b * 4096 + (u & 63) * 64 : MX + b * 256 + (u & 3) * 64, gr = lat ? (u & 63) : 0;
        if ((F.wave & 1) == 0) na_unit<0>(F, b, q0, lat, gr); else na_unit<1>(F, b, q0, lat, gr); }
    __syncthreads();
}

__device__ __forceinline__ void cm_unit(const Frame& F, int l, int row0) {
    int lane = F.lane; asm volatile("" : "+v"(lane));
    const int r32 = lane & 31, hi = lane >> 5, wid = F.wave;
    const bf16_t* U = wsb(F, WS_U); const bf16_t* V = wsb(F, WS_V); bf16_t* Y = wsb(F, WS_Y); const bf16_t* WSP = layer_w(F, l, OFF_WSP);
    LAS unsigned char* L = F.lds;
    __syncthreads();
    { const f32x4 gv = *(const f32x4*)(inp(F, IN_GV) + l * 256 + 4 * lane), bv = *(const f32x4*)(inp(F, IN_BV) + l * 256 + 4 * lane);
      u32x2 w[16];
#pragma unroll
      for (int i = 0; i < 16; ++i) w[i] = *(const u32x2*)(V + (size_t)(row0 + wid * 16 + i) * 256 + 4 * lane);
#pragma unroll
      for (int i = 0; i < 16; ++i) { const int q = wid * 16 + i;
          f32x4 x = (f32x4){bf_lo(w[i].x), bf_hi(w[i].x), bf_lo(w[i].y), bf_hi(w[i].y)};
          const float mu = wave_sum((x[0] + x[1]) + (x[2] + x[3])) * (1.0f / 256.0f); x = x - mu;
          const float rs = __builtin_amdgcn_rsqf(wave_sum((x[0] * x[0] + x[1] * x[1]) + (x[2] * x[2] + x[3] * x[3])) * (1.0f / 256.0f) + EPS);
          x = x * rs * gv + bv;
#pragma unroll
          for (int j = 0; j < 4; ++j) *(LAS unsigned short*)(L + (4 * lane + j) * 272 + q * 2) = (unsigned short)f2bf(x[j]); } }
    __syncthreads();
    const int g = wid >> 1, ph = wid & 1;
    const float* bsp = inp(F, IN_BSP) + (l * 4 + g) * 128 + ph * 64 + 4 * hi;
    f32x16 acc[2][2];
#pragma unroll
    for (int pb = 0; pb < 2; ++pb)
#pragma unroll
        for (int r = 0; r < 16; ++r) { const float bs = bsp[pb * 32 + (r & 3) + 8 * (r >> 2)]; acc[pb][0][r] = bs; acc[pb][1][r] = bs; }
#pragma unroll
    for (int ks = 0; ks < 8; ++ks) { bf16x8 a[2], bq[2];
#pragma unroll
        for (int pb = 0; pb < 2; ++pb) a[pb] = *(const bf16x8*)(WSP + (size_t)(g * 128 + ph * 64 + pb * 32 + r32) * 128 + ks * 16 + hi * 8);
#pragma unroll
        for (int cb = 0; cb < 2; ++cb) bq[cb] = *(const LAS bf16x8*)(L + (g * 64 + cb * 32 + r32) * 272 + (ks * 16 + hi * 8) * 2);
#pragma unroll
        for (int pb = 0; pb < 2; ++pb)
#pragma unroll
            for (int cb = 0; cb < 2; ++cb) acc[pb][cb] = mfma32(a[pb], bq[cb], acc[pb][cb]); }
    const int tid = wid * 64 + lane, tk = tid >> 5, c8 = tid & 31;
    u32x4 uv[8];
#pragma unroll
    for (int i = 0; i < 8; ++i) uv[i] = *(const u32x4*)(U + (size_t)(row0 + tk + 16 * i) * 256 + c8 * 8);
    __syncthreads();
#pragma unroll
    for (int pb = 0; pb < 2; ++pb)
#pragma unroll
        for (int r = 0; r < 16; ++r)
#pragma unroll
            for (int cb = 0; cb < 2; ++cb) *(LAS float*)(L + (ph * 64 + pb * 32 + (r & 3) + 8 * (r >> 2) + 4 * hi) * 1040 + (g * 64 + cb * 32 + r32) * 4) = acc[pb][cb][r];
    __syncthreads();
#pragma unroll
    for (int i = 0; i < 8; ++i) { const LAS f32x4* tp = (const LAS f32x4*)(L + (tk + 16 * i) * 1040 + c8 * 32); const f32x4 t0 = tp[0], t1 = tp[1]; const u32x4 u4 = uv[i];
        u32x4 y; y.x = pk2(bf_lo(u4.x) * t0[0], bf_hi(u4.x) * t0[1]); y.y = pk2(bf_lo(u4.y) * t0[2], bf_hi(u4.y) * t0[3]);
        y.z = pk2(bf_lo(u4.z) * t1[0], bf_hi(u4.z) * t1[1]); y.w = pk2(bf_lo(u4.w) * t1[2], bf_hi(u4.w) * t1[3]);
        *(u32x4*)(Y + (size_t)(row0 + tk + 16 * i) * 1024 + 768 + c8 * 8) = y; }
}
__device__ __forceinline__ void phase_cm(const Frame& F, int l, bool with_ctx) {
    for (int u = F.vcu; u < 256; u += F.G) cm_unit(F, l, u * 128);
    if (with_ctx) for (int u = F.G - 33 - F.vcu; u >= 0 && u < 16; u += F.G) cm_unit(F, l, MX + u * 128);
    __syncthreads();
}

constexpr int CW_BARS = 131072;
#define DBG_SRC WS_Y
#define DBG_LD 96
#define DBG_C0 0
#define DBG_W 96
#ifndef STOP_AFTER
#define STOP_AFTER 22
#endif
constexpr int N_PHASES = STOP_AFTER + 1;
#ifndef MK_N_LAUNCHES
#define MK_N_LAUNCHES 1
#endif
struct Args { const float* in[29]; float* out; unsigned char* ws; int ph_lo, ph_hi, li, hm_tiles; };
static_assert(sizeof(Args) == 29 * 8 + 8 + 8 + 16, "Args has no padding");

template <int LAYER>
__device__ __forceinline__ void mixer_gemm1(const Frame& F) {
    SchedG1 S{(const char*)wsb(F, WS_N), (const char*)layer_w(F, LAYER, OFF_WIN), F.G, (int)blockIdx.x, LAYER};
    EpiG1 E{wsb(F, WS_CKV), wsb(F, WS_NAQ), wsb(F, WS_NAK), wsb(F, WS_U), wsb(F, WS_V), wsb(F, WS_CQ), wsb(F, WS_K), wsb(F, WS_NAVT), (float*)(F.ws + WS_SSQ), (const float*)(F.ws + WS_TAB)};
    pg8::gemm_phase<EpiG1, SchedG1, false>(F.lds, 2048, 2048, S, E, F.tid);
}
template <int LAYER>
__device__ __forceinline__ void mixer_gemm2(const Frame& F) {
    { SchedPlain S{(const char*)wsb(F, WS_CQ), (const char*)layer_w(F, LAYER, OFF_WUQ), 768, 768, 6, LAYER == 0 ? 136 : 128, 3, F.G, (int)blockIdx.x};
      EpiG2Q E{wsb(F, WS_Q), (const float*)(F.ws + WS_SSQ), (const float*)(F.ws + WS_TAB)};
      pg8::gemm_phase<EpiG2Q, SchedPlain, false>(F.lds, 768, 768, S, E, F.tid); }
    { SchedG2KV S{(const char*)wsb(F, WS_CKV), (const char*)layer_w(F, LAYER, OFF_WUKV), F.G, F.G - 1 - (int)blockIdx.x};
      EpiG2KV E{wsb(F, WS_K), wsb(F, WS_VT), (const float*)(F.ws + WS_SSQ)};
      pg8::gemm_phase<EpiG2KV, SchedG2KV, false>(F.lds, 512, 512, S, E, F.tid); }
}
template <int LAYER>
__device__ __forceinline__ void mixer_merge(const Frame& F) {
    SchedG3 S{(const char*)F.out, (const char*)wsb(F, WS_Y), (const char*)layer_w(F, LAYER, OFF_WGL), (const char*)layer_w(F, LAYER, OFF_WBR), LAYER == 0 ? 32 : 0, F.G, (int)blockIdx.x, 1};
    EpiG3 E{wsb(F, WS_Z), F.ws + WS_GSCR + (size_t)blockIdx.x * 262144, wsb(F, WS_ZP), 0.03125f};
    pg8::gemm_phase<EpiG3, SchedG3, false, false, true>(F.lds, 2048, 2048, S, E, F.tid);
}
struct SchedCtxSplit {
    const char* A; const char* B; const char* AP; int lda2, ldb2, nt, split, G, c;
    __device__ __forceinline__ bool next(int i, pg8::Unit& u) const {
        const int L = i * G + c;
        if (L < 512) { int pm, pn; static_tile(L, 128, 4, pm, pn); u.A = A + (size_t)pm * 256 * lda2; u.B = B + (size_t)pn * 256 * ldb2; u.nt = nt; u.job = 0; u.pm = pm; u.pn = pn; return true; }
        const int nx = (512 - c + G - 1) / G, p = c + (i - nx) * G; if (p >= 32 * split) return false;
        const int T = p / split, s = p - T * split, pmc = T >> 2, pn = T & 3; u.pm = 128 + pmc; u.pn = pn; u.job = 1 + s;
        if (split == 3) { u.A = AP + ((size_t)s * MC + pmc * 256) * lda2; u.B = B + (size_t)pn * 256 * ldb2; u.nt = nt; }
        else { const int h0 = ((nt / 2) + 1) & ~1;
            u.A = A + (size_t)(128 + pmc) * 256 * lda2 + (size_t)s * h0 * 128; u.B = B + (size_t)pn * 256 * ldb2 + (size_t)s * h0 * 128; u.nt = s ? nt - h0 : h0; }
        return true;
    }
};
struct EpiCtxSplit {
    bf16_t* O; bf16_t* P0; bf16_t* P1; float sc;
    __device__ __forceinline__ void operator()(const AccT& acc, const pg8::Unit& u, int wr, int wc, int fr, int fq) const {
        bf16_t* base = (u.job == 0) ? O + (size_t)u.pm * 256 * 1024 : ((u.job == 1) ? P0 : P1 + (size_t)(u.job - 2) * MC * 1024) + (size_t)(u.pm - 128) * 256 * 1024;
#pragma unroll
        for (int ai = 0; ai < 2; ++ai)
#pragma unroll
            for (int m = 0; m < 4; ++m) { bf16_t* rowp = base + (size_t)(ai * 128 + wr * 64 + m * 16 + fr) * 1024 + u.pn * 256 + wc * 32 + fq * 8;
#pragma unroll
                for (int bj = 0; bj < 2; ++bj) *(u32x4*)(rowp + bj * 128) = pack8(acc[ai][bj][m][0] * sc, acc[ai][bj][m][1] * sc); }
    }
};
template <int LAYER>
__device__ __forceinline__ void mixer_out(const Frame& F) {
    if (LAYER == 0) {
        SchedCtxSplit S{(const char*)wsb(F, WS_Z), (const char*)layer_w(F, LAYER, OFF_WOUT), (const char*)wsb(F, WS_ZP), 2048, 2048, 16, 3, F.G, (int)blockIdx.x};
        EpiCtxSplit E{wsb(F, WS_O), wsb(F, WS_OP), wsb(F, WS_OP) + (size_t)MC * 1024, 1.0f};
        pg8::gemm_phase<EpiCtxSplit, SchedCtxSplit, false>(F.lds, 2048, 2048, S, E, F.tid);
    } else {
        SchedPlain S{(const char*)wsb(F, WS_Z), (const char*)layer_w(F, LAYER, OFF_WOUT), 2048, 2048, 16, 128, 4, F.G, (int)blockIdx.x};
        EpiPlain E{wsb(F, WS_O), 1024};
        pg8::gemm_phase<EpiPlain, SchedPlain, false>(F.lds, 2048, 2048, S, E, F.tid);
    }
}

__global__ void __launch_bounds__(NTHR, 2) fwd(Args args) {
    extern __shared__ __attribute__((aligned(16))) unsigned char lds[];
    Frame F;
    F.lds = (LAS unsigned char*)lds; F.MISC = (volatile LAS unsigned*)(F.lds + LDS_MISC);
    F.tid = threadIdx.x; F.lane = F.tid & 63; F.wave = __builtin_amdgcn_readfirstlane(F.tid >> 6);
    F.G = gridDim.x; { const int bx = blockIdx.x; F.vcu = (F.G % 8 == 0) ? (bx % 8) * (F.G / 8) + bx / 8 : bx; }
    F.ws = args.ws; F.ctl = (unsigned*)(args.ws + WS_CTL); F.out = args.out; F.hm_tiles = args.hm_tiles;
    for (int u = F.tid; u < (LDS_BYTES - LDS_MISC) / 4; u += NTHR) ((LAS unsigned*)(F.lds + LDS_MISC))[u] = 0u;
    __syncthreads();
    if (F.tid == 0) {
#pragma unroll
        for (int i = 0; i < 29; ++i) { const unsigned long long p = (unsigned long long)args.in[i]; F.MISC[MI_IN + 2 * i] = (unsigned)p; F.MISC[MI_IN + 2 * i + 1] = (unsigned)(p >> 32); } }
    __syncthreads();
    const XcdBarrier bar = xcd_barrier_post(F.ctl + CW_BARS + args.li * 4096, F.MISC);
    const int lo = args.ph_lo, hi = args.ph_hi;
#ifndef ONLYP
#define ONLYP -1
#endif
#ifndef PROBE_DUP
#define PROBE_DUP 0
#endif
#define DUPN(k) for (int rep_ = 0; rep_ < ((PROBE_DUP == (k)) ? 2 : 1); ++rep_)
#define IN(k) ((ONLYP < 0 || ONLYP == (k)) && lo <= (k) && (k) < hi)
#define SEAM(k) do { if (IN((k) + 1)) xcd_barrier(bar, F.tid); } while (0)
#define REFRESH() do { int l_; asm volatile("v_mbcnt_lo_u32_b32 %0, -1, 0\n\tv_mbcnt_hi_u32_b32 %0, -1, %0" : "=v"(l_)); F.lane = l_; F.tid = F.wave * 64 + l_; } while (0)
    LAS float* tscr = (LAS float*)(F.lds + 32768 + F.wave * 8448);

    if (IN(0)) { REFRESH(); p0_convert_small(F, tscr); p0_mods(F); SEAM(0); }
    if (IN(1)) { REFRESH(); phase_T0(F); SEAM(1); }
    if (IN(2)) { DUPN(4) { REFRESH(); mixer_gemm1<0>(F); } SEAM(2); }
    if (IN(3)) { DUPN(4) { REFRESH(); mixer_gemm2<0>(F); } SEAM(3); }
    if (IN(4)) { DUPN(2) { REFRESH(); phase_mla(F, true); REFRESH(); phase_na(F, 0, true); REFRESH(); phase_cm(F, 0, true); } if (IN(7)) xcd_barrier(bar, F.tid); }
    if (IN(7)) { DUPN(1) { REFRESH(); mixer_merge<0>(F); } SEAM(7); }
    if (IN(8)) { DUPN(6) { REFRESH(); mixer_out<0>(F); } SEAM(8); }
    if (IN(9)) { REFRESH(); phase_T1<false>(F, 0); SEAM(9); }
    if (IN(10)) { DUPN(5) { REFRESH(); SchedPlain S{(const char*)wsb(F, WS_N), (const char*)wsb(F, WS_WF13), 1024, 1024, 8, 136, 22, F.G, (int)blockIdx.x}; EpiSwigluF8 E{F.ws + WS_HMID, DFF, 0};
        pg8::gemm_phase<EpiSwigluF8, SchedPlain, false, true>(F.lds, 1024, 1024, S, E, F.tid); } SEAM(10); }
    if (IN(11)) { DUPN(5) { REFRESH(); SchedCtxSplit S{(const char*)wsb(F, WS_HMID), (const char*)wsb(F, WS_WF2), nullptr, DFF, DFF, DFF / 128, 2, F.G, (int)blockIdx.x};
        EpiCtxSplit E{wsb(F, WS_F), wsb(F, WS_F) + (size_t)MX * 1024, wsb(F, WS_FP), 0.015625f};
        pg8::gemm_phase<EpiCtxSplit, SchedCtxSplit, false, true>(F.lds, DFF, DFF, S, E, F.tid); } SEAM(11); }
    if (IN(12)) { REFRESH(); phase_T2<false, false>(F, 0); SEAM(12); }
    if (IN(13)) { DUPN(4) { REFRESH(); mixer_gemm1<1>(F); } SEAM(13); }
    if (IN(14)) { DUPN(4) { REFRESH(); mixer_gemm2<1>(F); } SEAM(14); }
    if (IN(15)) { DUPN(2) { REFRESH(); phase_mla(F, false); REFRESH(); phase_na(F, 1, false); REFRESH(); phase_cm(F, 1, false); } if (IN(18)) xcd_barrier(bar, F.tid); }
    if (IN(18)) { DUPN(1) { REFRESH(); mixer_merge<1>(F); } SEAM(18); }
    if (IN(19)) { DUPN(6) { REFRESH(); mixer_out<1>(F); } SEAM(19); }
    if (IN(20)) { REFRESH(); p0_convert_moe(F, tscr); phase_T1<true>(F, 1); SEAM(20); }
    if (IN(21)) { REFRESH();
        __syncthreads();
        if (F.tid == 0) { unsigned tb = 0;
            for (int e = 0; e < 8; ++e) { const unsigned c = __hip_atomic_load(F.ctl + CW_CNT + 64 * e, __ATOMIC_RELAXED, __HIP_MEMORY_SCOPE_AGENT); F.MISC[MI_CNT + e] = c; F.MISC[MI_TB + e] = tb; tb += (c + 255u) >> 8; }
            F.MISC[MI_TB + 8] = tb; }
        __syncthreads();
        const int T_tot = __builtin_amdgcn_readfirstlane((int)F.MISC[MI_TB + 8]);
        {
            const unsigned char* N8 = F.ws + WS_N8M; unsigned char* XG = F.ws + WS_XG; const int* LT = (const int*)(F.ws + WS_LTOK);
            int tbv[9], cntv[8];
#pragma unroll
            for (int j = 0; j < 9; ++j) tbv[j] = __builtin_amdgcn_readfirstlane((int)F.MISC[MI_TB + j]);
#pragma unroll
            for (int j = 0; j < 8; ++j) cntv[j] = __builtin_amdgcn_readfirstlane((int)F.MISC[MI_CNT + j]);
            const int R0 = F.vcu * NWAVES + F.wave, RS = F.G * NWAVES, NR = T_tot * 256;
            for (int Rb = R0; Rb < NR; Rb += 4 * RS) {
                int tok[4];
#pragma unroll
                for (int k = 0; k < 4; ++k) { const int R = Rb + k * RS; tok[k] = 0;
                    if (R < NR) { const int gt = R >> 8; int e = 0, tbe = 0, ce = cntv[0];
#pragma unroll
                        for (int j = 1; j < 8; ++j) if (tbv[j] <= gt) { e = j; tbe = tbv[j]; ce = cntv[j]; }
                        const int pos = (gt - tbe) * 256 + (R & 255); if (pos < ce) tok[k] = LT[e * 32768 + pos] >> 1; } }
                u32x4 row[4];
#pragma unroll
                for (int k = 0; k < 4; ++k) row[k] = *(const u32x4*)(N8 + (size_t)tok[k] * 1024 + F.lane * 16);
#pragma unroll
                for (int k = 0; k < 4; ++k) { const int R = Rb + k * RS; if (R < NR) *(u32x4*)(XG + (size_t)R * 1024 + F.lane * 16) = row[k]; } }
            xcd_barrier(bar, F.tid);
        }
#define TBR(j_) __builtin_amdgcn_readfirstlane((int)F.MISC[MI_TB + (j_)])
        for (int t_lo = 0; t_lo < T_tot; t_lo += F.hm_tiles) { const int t_hi = (t_lo + F.hm_tiles < T_tot) ? t_lo + F.hm_tiles : T_tot;
            DUPN(3) { SchedMoeUp S{(const char*)(F.ws + WS_XG), (const char*)(F.ws + WS_WM13), F.MISC, t_lo, t_hi, F.G, (int)blockIdx.x, {TBR(1), TBR(2), TBR(3), TBR(4), TBR(5), TBR(6), TBR(7)}}; EpiSwigluF8 E{F.ws + WS_HM, DFE, t_lo};
              pg8::gemm_phase<EpiSwigluF8, SchedMoeUp, false, true>(F.lds, 1024, 1024, S, E, F.tid); }
            xcd_barrier(bar, F.tid);
            DUPN(8) { SchedMoeDown S{(const char*)wsb(F, WS_HM), (const char*)wsb(F, WS_WM2), F.MISC, t_lo, t_hi, F.G, (int)blockIdx.x, {TBR(1), TBR(2), TBR(3), TBR(4), TBR(5), TBR(6), TBR(7)}};
              EpiMoeDown E{wsb(F, WS_Y2), (const int*)(F.ws + WS_LTOK), (const float*)(F.ws + WS_LW), F.MISC};
              pg8::gemm_phase<EpiMoeDown, SchedMoeDown, false, true>(F.lds, DFE, DFE, S, E, F.tid); }
            xcd_barrier(bar, F.tid);
        }
    }
    if (IN(22)) { REFRESH(); phase_T2<true, true>(F, 1); }
#ifdef DBG_DUMP_HC
    if (lo == 100) { const bf16_t* SRC = wsb(F, DBG_SRC); const int gw = F.vcu * NWAVES + F.wave;
        for (int r = gw; r < MX; r += F.G * NWAVES) for (int c = F.lane; c < 1024; c += 64) F.out[(size_t)r * 1024 + c] = bf_lo((unsigned)SRC[(size_t)r * 1024 + (c % 512)]); }
#endif
#undef IN
#undef SEAM
}

extern "C" void kernel_launch(void* const* d_in, const int* in_sizes, int n_in, void* d_out, int out_size, void* d_ws, size_t ws_size, hipStream_t stream) {
    static int grid = 0; static int hm_tiles = 0;
    if (grid == 0) {
        if (n_in != 29 || out_size != MX * DM) { fprintf(stderr, "kernel_launch: unexpected problem shape (n_in %d, out %d)\n", n_in, out_size); grid = -1; return; }
        const size_t avail = ws_size > WS_HM ? (ws_size - WS_HM) / HM_TILE_BYTES : 0;
        if (ws_size < WS_END || avail < 8) { fprintf(stderr, "kernel_launch: workspace too small: %zu bytes (need %zu for the mixer, %zu + 8 tiles for the experts)\n", ws_size, (size_t)WS_MIX_END, (size_t)WS_HM); grid = -1; return; }
        const int maxt = avail > 264 ? 264 : (int)avail; const int npass = (264 + maxt - 1) / maxt; hm_tiles = (264 + npass - 1) / npass;
        int dev = 0, cus = 0;
        if (hipGetDevice(&dev) != hipSuccess || hipDeviceGetAttribute(&cus, hipDeviceAttributeMultiprocessorCount, dev) != hipSuccess) { grid = -1; return; }
        if (hipFuncSetAttribute((const void*)fwd, hipFuncAttributeMaxDynamicSharedMemorySize, LDS_BYTES) != hipSuccess) { fprintf(stderr, "kernel_launch: hipFuncSetAttribute failed\n"); grid = -1; return; }
        int per_cu = 0;
        if (hipOccupancyMaxActiveBlocksPerMultiprocessor(&per_cu, (const void*)fwd, NTHR, LDS_BYTES) != hipSuccess || per_cu < 1) fprintf(stderr, "kernel_launch: occupancy query reports %d\n", per_cu);
        (void)hipGetLastError();
        grid = cus > 256 ? 256 : cus;
        fprintf(stderr, "kernel_launch: grid %d, hm_tiles %d, ws %zu MiB (mixer end %zu MiB, HM at %zu MiB)\n", grid, hm_tiles, ws_size >> 20, (size_t)(WS_MIX_END >> 20), (size_t)(WS_HM >> 20));
    }
    if (grid < 0) return;
    if (hipMemsetAsync((char*)d_ws + WS_CTL, 0, CTL_ZERO_BYTES, stream) != hipSuccess) return;
    Args a{};
    for (int i = 0; i < 29; ++i) a.in[i] = (const float*)d_in[i];
    a.out = (float*)d_out; a.ws = (unsigned char*)d_ws; a.hm_tiles = hm_tiles;
    if (MK_N_LAUNCHES == 1) { a.ph_lo = 0; a.ph_hi = N_PHASES; a.li = 0; hipLaunchKernelGGL(fwd, dim3(grid), dim3(NTHR), LDS_BYTES, stream, a); }
    else for (int li = 0; li < N_PHASES; ++li) { a.ph_lo = li; a.ph_hi = li + 1; a.li = li; hipLaunchKernelGGL(fwd, dim3(grid), dim3(NTHR), LDS_BYTES, stream, a); }
#ifdef DBG_DUMP_HC
    a.ph_lo = 100; a.ph_hi = 101; a.li = 23; hipLaunchKernelGGL(fwd, dim3(grid), dim3(NTHR), LDS_BYTES, stream, a);
#endif
}
```

```cpp
#include <hip/hip_runtime.h>
#include <stdint.h>
#include <stdio.h>

#define LAS __attribute__((address_space(3)))
#define GAS __attribute__((address_space(1)))
typedef unsigned short bf16_t;
typedef short bf16x8 __attribute__((ext_vector_type(8)));
typedef short s16x4 __attribute__((ext_vector_type(4)));
typedef float f32x4 __attribute__((ext_vector_type(4)));
typedef float f32x2 __attribute__((ext_vector_type(2)));
typedef float f32x16 __attribute__((ext_vector_type(16)));
typedef unsigned u32x4 __attribute__((ext_vector_type(4)));
typedef unsigned u32x2 __attribute__((ext_vector_type(2)));

constexpr int NB = 8, SEQ = 4096, DM = 1024, CTX = 256, NLAYER = 2;
constexpr int MX = NB * SEQ;
constexpr int MC = NB * CTX;
constexpr int MT = MX + MC;
constexpr int LK = CTX + SEQ;
constexpr int INW = 5024;
constexpr int DFF = 2816, DFE = 3584, NEXP = 8;
constexpr float EPS = 1e-6f;
constexpr float LOG2E = 1.4426950408889634f;
constexpr int NWAVES = 8, NTHR = 512;

constexpr size_t MiB = 1u << 20;
constexpr size_t WS_CTL = 0;
constexpr size_t CTL_ZERO_BYTES = 1 * MiB;
constexpr size_t WS_TAB = 1 * MiB;
constexpr size_t WS_LTOK = WS_TAB + 65536;
constexpr size_t WS_LW = WS_LTOK + 8 * 32768 * 4;
constexpr size_t WS_SSQ = WS_LW + 8 * 32768 * 4;
constexpr size_t WS_W0 = 6 * MiB;
constexpr size_t SZ_WIN = (size_t)2048 * 1024 * 2;
constexpr size_t SZ_WGL = (size_t)3072 * 1024 * 2;
constexpr size_t SZ_WUQ = (size_t)768 * 384 * 2;
constexpr size_t SZ_WUKV = (size_t)1024 * 256 * 2;
constexpr size_t SZ_WBR = (size_t)1024 * 1024 * 2;
constexpr size_t SZ_WOUT = (size_t)1024 * 1024 * 2;
constexpr size_t SZ_WSP = (size_t)4 * 128 * 128 * 2;
constexpr size_t OFF_WIN = 0, OFF_WGL = OFF_WIN + SZ_WIN, OFF_WUQ = OFF_WGL + SZ_WGL, OFF_WUKV = OFF_WUQ + SZ_WUQ, OFF_WBR = OFF_WUKV + SZ_WUKV,
                 OFF_WOUT = OFF_WBR + SZ_WBR, OFF_WSP = OFF_WOUT + SZ_WOUT, SZ_LAYERW = OFF_WSP + SZ_WSP;
constexpr size_t WS_WF13 = WS_W0 + 2 * SZ_LAYERW;
constexpr size_t WS_WF2 = WS_WF13 + (size_t)5632 * 1024 * 2;
constexpr size_t WS_HC = WS_WF2 + (size_t)1024 * 2816 * 2;
constexpr size_t WS_N = WS_HC + (size_t)MC * DM * 4;
constexpr size_t WS_ARENA = WS_N + (size_t)MT * DM * 2;
constexpr size_t WS_HB1 = WS_W0;
constexpr size_t WS_N8M = WS_N + 36 * MiB;
static_assert(WS_HB1 + (size_t)MX * 1024 * 2 <= WS_N8M && WS_N8M + (size_t)MX * 1024 <= WS_ARENA, "expert-layer h and fp8 input fit below the arena");
constexpr size_t WS_Y = WS_ARENA;
constexpr size_t WS_CQ = WS_Y + (size_t)MT * 1024 * 2;
constexpr size_t WS_CKV = WS_CQ + (size_t)MT * 384 * 2;
constexpr size_t WS_U = WS_CKV + (size_t)MT * 256 * 2;
constexpr size_t WS_V = WS_U + (size_t)MT * 256 * 2;
constexpr size_t WS_NAQ = WS_V + (size_t)MT * 256 * 2;
constexpr size_t WS_NAK = WS_NAQ + (size_t)MT * 256 * 2;
constexpr size_t WS_NAVT = WS_NAK + (size_t)MT * 256 * 2;
constexpr size_t WS_Q = WS_NAVT + (size_t)NB * 256 * LK * 2;
constexpr size_t WS_K = WS_Q + (size_t)MT * 768 * 2;
constexpr size_t WS_VT = WS_K + (size_t)NB * 8 * LK * 96 * 2;
constexpr size_t WS_GSCR = WS_VT + (size_t)NB * 8 * 64 * LK * 2;
constexpr size_t WS_MIX_END = WS_GSCR + (size_t)256 * 262144;
constexpr size_t WS_ZP = WS_NAQ;
constexpr size_t WS_OP = WS_Y;
constexpr size_t WS_FP = WS_VT;
static_assert(WS_ZP + (size_t)3 * MC * 1024 * 2 <= WS_Q && WS_CQ + (size_t)MT * 1024 * 2 <= WS_NAQ, "ZP clear of O");
static_assert(WS_FP >= WS_ARENA + (size_t)MT * DFF * 2 + (size_t)MT * 1024 * 2, "FP clear of HMID and F");
constexpr size_t WS_HB = WS_MIX_END;
constexpr size_t WS_END = WS_HB + (size_t)MX * 1024 * 2;
constexpr size_t WS_O = WS_CQ;
constexpr size_t WS_Z = WS_Q;
static_assert(WS_O + (size_t)MT * 1024 * 2 <= WS_NAQ, "O alias");
static_assert(WS_Z + (size_t)MT * 1024 * 2 <= WS_VT, "Z alias");
constexpr size_t WS_HMID = WS_ARENA;
constexpr size_t WS_F = WS_HMID + (size_t)MT * DFF * 2;
constexpr size_t WS_Y2 = WS_ARENA;
constexpr size_t WS_WM13 = WS_O + (size_t)MT * 1024 * 2;
constexpr size_t WS_WM2 = WS_WM13 + (size_t)8 * 7168 * 1024;
constexpr size_t WS_HM = WS_WM2 + (size_t)8 * 1024 * 3584;
static_assert(WS_Y2 + (size_t)MX * 2048 * 2 <= WS_WM13, "Y2 vs WM13");
constexpr size_t HM_TILE_BYTES = (size_t)256 * DFE;
constexpr size_t WS_XG = WS_O;
static_assert((size_t)264 * 256 * 1024 <= (size_t)MT * 1024 * 2, "XG fits the O region");

constexpr int CW_BAR = 1024;
constexpr int CW_CNT = 8192;
constexpr int CW_MOD = 16384;
static_assert((CW_MOD + 2 * 9 * 6144) * 4 <= (int)CTL_ZERO_BYTES, "CTL");

constexpr int LDS_BYTES = 150528;
constexpr int LDS_MISC = 147456;

__device__ __forceinline__ unsigned f2bf(float f) { unsigned u = __builtin_bit_cast(unsigned, f); return (u + 0x7fffu + ((u >> 16) & 1u)) >> 16; }
typedef float pk2_f32x2 __attribute__((ext_vector_type(2))); typedef __bf16 pk2_bf16x2 __attribute__((ext_vector_type(2)));
__device__ __forceinline__ unsigned pk2(float lo, float hi) { pk2_f32x2 v = {lo, hi}; pk2_bf16x2 b = __builtin_convertvector(v, pk2_bf16x2); return __builtin_bit_cast(unsigned, b); }
__device__ __forceinline__ float bf_lo(unsigned w) { return __builtin_bit_cast(float, w << 16); }
__device__ __forceinline__ float bf_hi(unsigned w) { return __builtin_bit_cast(float, w & 0xffff0000u); }
__device__ __forceinline__ float wave_sum(float v) {
#pragma unroll
    for (int o = 1; o < 64; o <<= 1) v += __shfl_xor(v, o);
    return v;
}
__device__ __forceinline__ float fast_exp2(float x) { return __builtin_amdgcn_exp2f(x); }
__device__ __forceinline__ float sigmoidf_(float x) { return __builtin_amdgcn_rcpf(1.0f + fast_exp2(-x * LOG2E)); }
__device__ __forceinline__ int pk4_fp8(float a, float b, float c, float d) { int w = 0; w = __builtin_amdgcn_cvt_pk_fp8_f32(a, b, w, false); w = __builtin_amdgcn_cvt_pk_fp8_f32(c, d, w, true); return w; }
__device__ __forceinline__ float clamp8(float x) { return fminf(fmaxf(x, -440.0f), 440.0f); }
#define LDS_WAIT() asm volatile("s_waitcnt lgkmcnt(0)" ::: "memory")
#define VM_WAIT() asm volatile("s_waitcnt vmcnt(0)" ::: "memory")

#define XB_TMO      128
#define XB_XCNT(j)  (256  + 64 * (j))
#define XB_XSUB(j)  (1280 + 64 * (j))
#define XB_XGEN(j)  (2304 + 64 * (j))
#define XB_TOP      3328
#define XB_TOPGEN   3392
#define XCD_BAR_WORDS 3456
#define XB_SPIN_CAP (1u << 18)
__device__ __forceinline__ unsigned xb_ld(unsigned* p)              { return __hip_atomic_load(p, __ATOMIC_RELAXED, __HIP_MEMORY_SCOPE_AGENT); }
__device__ __forceinline__ unsigned xb_add(unsigned* p, unsigned v) { return __hip_atomic_fetch_add(p, v, __ATOMIC_RELAXED, __HIP_MEMORY_SCOPE_AGENT); }
__device__ __forceinline__ unsigned xb_xcc_id() { return (unsigned)__builtin_amdgcn_s_getreg((3 << 11) | 20) & 0xFu; }
#define XB_SPIN(cond, bar) do { unsigned _sp = 0; while (cond) { __builtin_amdgcn_s_sleep(1); \
    if ((++_sp & 255u) == 0u) { if (xb_ld(&(bar)[XB_TMO])) break; if (_sp > XB_SPIN_CAP) { atomicAdd(&(bar)[XB_TMO], 1u); break; } } } } while (0)
struct XcdBarrier { unsigned* bar; unsigned x; volatile LAS unsigned* st; };
__device__ __forceinline__ XcdBarrier xcd_barrier_post(unsigned* bar, volatile LAS unsigned* st) {
    XcdBarrier b; b.bar = bar; b.x = xb_xcc_id(); b.st = st;
    if (threadIdx.x == 0) (void)xb_add(&bar[XB_XCNT(b.x)], 1u);
    return b;
}
__device__ __forceinline__ void xcd_barrier_complete(unsigned* bar, unsigned x, unsigned& nloc, unsigned& nx) {
    const unsigned G = gridDim.x * gridDim.y * gridDim.z;
    unsigned sum, cnt, mine, sp = 0u;
    for (;;) {
        sum = 0u; cnt = 0u; mine = 0u;
#pragma unroll
        for (unsigned j = 0; j < 16; ++j) { const unsigned c = xb_ld(&bar[XB_XCNT(j)]); sum += c; cnt += (c > 0u) ? 1u : 0u; mine = (j == x) ? c : mine; }
        if (sum == G) break;
        __builtin_amdgcn_s_sleep(1);
        if ((++sp & 255u) == 0u) { if (xb_ld(&bar[XB_TMO])) break; if (sp > XB_SPIN_CAP) { atomicAdd(&bar[XB_TMO], 1u); break; } }
    }
    nloc = mine > 0u ? mine : 1u; nx = cnt > 0u ? cnt : 1u;
}
__device__ __forceinline__ void xcd_barrier(const XcdBarrier& b, const int tid_) {
    asm volatile("s_waitcnt vmcnt(0)" ::: "memory");
    __syncthreads();
    if (tid_ == 0) {
        unsigned* bar = b.bar;
        __builtin_amdgcn_s_waitcnt(0);
        unsigned nloc = b.st[0], nx = b.st[1];
        if (nloc == 0u) { xcd_barrier_complete(bar, b.x, nloc, nx); b.st[0] = nloc; b.st[1] = nx; }
        const unsigned old = xb_add(&bar[XB_XSUB(b.x)], 1u);
        const unsigned gen = old / nloc;
        if (old + 1u == (gen + 1u) * nloc) {
            __builtin_amdgcn_fence(__ATOMIC_RELEASE, "agent");
            asm volatile("s_waitcnt vmcnt(0)" ::: "memory");
            const unsigned og = xb_add(&bar[XB_TOP], 1u);
            const unsigned tg = og / nx;
            if (og + 1u == (tg + 1u) * nx) xb_add(&bar[XB_TOPGEN], 1u);
            else XB_SPIN(xb_ld(&bar[XB_TOPGEN]) == tg, bar);
            __builtin_amdgcn_fence(__ATOMIC_ACQUIRE, "agent");
            xb_add(&bar[XB_XGEN(b.x)], 1u);
            asm volatile("s_waitcnt vmcnt(0)" ::: "memory");
        } else {
            XB_SPIN(xb_ld(&bar[XB_XGEN(b.x)]) == gen, bar);
            __builtin_amdgcn_fence(__ATOMIC_ACQUIRE, "agent");
            asm volatile("s_waitcnt vmcnt(0)" ::: "memory");
        }
    }
    __syncthreads();
}

namespace pg8 {
typedef int v8i_t __attribute__((ext_vector_type(8))); typedef int v4i_t __attribute__((ext_vector_type(4)));
__device__ __forceinline__ v8i_t cat8(bf16x8 a, bf16x8 b) { return __builtin_shufflevector(__builtin_bit_cast(v4i_t, a), __builtin_bit_cast(v4i_t, b), 0, 1, 2, 3, 4, 5, 6, 7); }
constexpr int BM = 256, BK = 64, HALF = 128, HTB = HALF * BK * 2, STAGE_BYTES = 8 * HTB;
__host__ __device__ __forceinline__ int lds_byte(int r, int c) { const int st = (r >> 4) * 2 + (c >> 5), rr = r & 15, cc = c & 31, ob = rr * 64 + cc * 2; return st * 1024 + (ob ^ (((ob >> 9) & 1) << 5)); }
__host__ __device__ __forceinline__ void stage_rc(int b, int& R, int& C) { const int st = b / 1024, sb = b % 1024, swz = sb ^ (((sb >> 9) & 1) << 5); R = (st >> 1) * 16 + swz / 64; C = (st & 1) * 32 + (swz % 64) / 2; }
__host__ __device__ __forceinline__ int perm32(int rho) { const int n = rho >> 4, i = rho & 15; return 8 * (i >> 2) + 4 * n + (i & 3); }

struct Unit { const char* A; const char* B; int nt; int job, pm, pn; int f8; };

template <class Epi, class Sched, bool GATHER, bool FP8 = false, bool MIXED = false>
__device__ __forceinline__ void gemm_phase(LAS unsigned char* lds, const int lda2, const int ldb2, const Sched& S, const Epi& E, const int tid_in) {
    const int tid = tid_in, wid = __builtin_amdgcn_readfirstlane(tid >> 6), lane = tid & 63, wr = wid >> 2, wc = wid & 3, fr = lane & 15, fq = lane >> 4;
    int Rr[2], Cc[2];
    unsigned voffA[2], voffB[2];
#pragma unroll
    for (int i = 0; i < 2; ++i) { int R, C; stage_rc(tid * 16 + i * 8192, R, C); const int Rb = (R & ~31) + perm32(R & 31);
        Rr[i] = R; Cc[i] = C; voffA[i] = (unsigned)(R * lda2 + C * 2); voffB[i] = (unsigned)(Rb * ldb2 + C * 2); }
    const size_t kstep = (size_t)(BK * 2);
    const size_t hstepA = (size_t)HALF * lda2, hstepB = (size_t)HALF * ldb2;
    const unsigned ldsw = (unsigned)wid * 1024u;
    const int aoff = lds_byte(wr * 64 + fr, fq * 8), boff = lds_byte(wc * 32 + fr, fq * 8);
#define PG8_SA(b, h) (((b) * 2 + (h)) * HTB)
#define PG8_SB(b, h) ((4 + (b) * 2 + (h)) * HTB)
#define PG8_STAGE(bufoff, gbase, voff) do { _Pragma("unroll") for (int _i = 0; _i < 2; ++_i) \
        __builtin_amdgcn_global_load_lds((const unsigned*)((const char*)(gbase) + (voff)[_i]), (LAS unsigned*)(lds + (bufoff) + ldsw + _i * 8192), 16, 0, 0); } while (0)
#define PG8_LDA(dst, b, h) do { _Pragma("unroll") for (int m = 0; m < 4; ++m) _Pragma("unroll") for (int k = 0; k < 2; ++k) dst[m][k] = *(const LAS bf16x8*)(lds + PG8_SA(b, h) + aoff + m * 2048 + k * 1024); } while (0)
#define PG8_LDB(dst, b, h) do { _Pragma("unroll") for (int n = 0; n < 2; ++n) _Pragma("unroll") for (int k = 0; k < 2; ++k) dst[n][k] = *(const LAS bf16x8*)(lds + PG8_SB(b, h) + boff + n * 2048 + k * 1024); } while (0)
#define PG8_MMA_F8(ai, bj, At, Bt) do { __builtin_amdgcn_s_setprio(1); \
        _Pragma("unroll") for (int m = 0; m < 4; ++m) _Pragma("unroll") for (int n = 0; n < 2; ++n) \
            asm volatile("s_nop 3\n\tv_mfma_scale_f32_16x16x128_f8f6f4 %0, %1, %2, %0, %3, %3 op_sel_hi:[0,0,0]" : "+v"(acc[ai][bj][m][n]) : "v"(cat8(Bt[n][0], Bt[n][1])), "v"(cat8(At[m][0], At[m][1])), "v"(sc8)); \
        __builtin_amdgcn_s_setprio(0); } while (0)
#define PG8_MMA_BF(ai, bj, At, Bt) do { __builtin_amdgcn_s_setprio(1); \
        _Pragma("unroll") for (int m = 0; m < 4; ++m) _Pragma("unroll") for (int n = 0; n < 2; ++n) _Pragma("unroll") for (int k = 0; k < 2; ++k) \
            acc[ai][bj][m][n] = __builtin_amdgcn_mfma_f32_16x16x32_bf16(Bt[n][k], At[m][k], acc[ai][bj][m][n], 0, 0, 0); \
        __builtin_amdgcn_s_setprio(0); } while (0)
#define PG8_WAIT_V(n) asm volatile("s_waitcnt vmcnt(" #n ")" ::: "memory")
#define PG8_WAIT_L(n) asm volatile("s_waitcnt lgkmcnt(" #n ")" ::: "memory")
#define PG8_BAR __builtin_amdgcn_s_barrier()
#define PG8_SCHED __builtin_amdgcn_sched_barrier(0)
    int sc8 = 0x7f7f7f7f; asm volatile("" : "+v"(sc8));
    Unit cur, nxt; int ui = 0;
    if (!S.next(0, cur)) return;
    f32x4 acc[2][2][4][2];
#pragma unroll
    for (int a = 0; a < 2; ++a)
#pragma unroll
        for (int b = 0; b < 2; ++b)
#pragma unroll
            for (int m = 0; m < 4; ++m)
#pragma unroll
                for (int n = 0; n < 2; ++n) acc[a][b][m][n] = (f32x4){0.f, 0.f, 0.f, 0.f};
    bf16x8 At[4][2], B0[2][2], B1[2][2];
    unsigned gC[2][2], gN[2][2];
    if constexpr (GATHER) {
#pragma unroll
        for (int h = 0; h < 2; ++h)
#pragma unroll
            for (int i = 0; i < 2; ++i) { gC[h][i] = S.a_row(cur, h * HALF + Rr[i]) * (unsigned)lda2 + (unsigned)(Cc[i] * 2); gN[h][i] = gC[h][i]; }
    }
#define PG8_STAGE_A(bufoff, kptr, h, useN) do { if constexpr (GATHER) { unsigned _o[2]; _o[0] = (useN) ? gN[h][0] : gC[h][0]; _o[1] = (useN) ? gN[h][1] : gC[h][1]; PG8_STAGE(bufoff, kptr, _o); } \
        else { PG8_STAGE(bufoff, (kptr) + (h) * hstepA, voffA); } } while (0)
    const char* cA = cur.A; const char* cB = cur.B;
    PG8_STAGE(PG8_SB(0, 0), cB, voffB); PG8_STAGE(PG8_SB(0, 1), cB + hstepB, voffB); PG8_STAGE_A(PG8_SA(0, 0), cA, 0, false); PG8_STAGE_A(PG8_SA(0, 1), cA, 1, false);
    if (wr == 1) PG8_BAR;
    PG8_WAIT_V(2); PG8_BAR;
    PG8_STAGE(PG8_SB(1, 0), cB + kstep, voffB); PG8_STAGE_A(PG8_SA(1, 0), cA + kstep, 0, false); PG8_STAGE(PG8_SB(1, 1), cB + hstepB + kstep, voffB);
    PG8_WAIT_V(6); PG8_BAR;
    for (;;) {
        const bool has_next = S.next(ui + 1, nxt);
        const char* nA = has_next ? nxt.A : cA; const char* nB = has_next ? nxt.B : cB;
        if constexpr (GATHER) {
            if (has_next) {
#pragma unroll
                for (int h = 0; h < 2; ++h)
#pragma unroll
                    for (int i = 0; i < 2; ++i) gN[h][i] = S.a_row(nxt, h * HALF + Rr[i]) * (unsigned)lda2 + (unsigned)(Cc[i] * 2);
            } else {
#pragma unroll
                for (int h = 0; h < 2; ++h)
#pragma unroll
                    for (int i = 0; i < 2; ++i) gN[h][i] = gC[h][i];
            }
        }
        int f8u = 0; if constexpr (MIXED) f8u = __builtin_amdgcn_readfirstlane(cur.f8);
        int nt = cur.nt; asm volatile("" : "+s"(nt));
#define PG8_KLOOP(MMF)         for (int t = 0; t < nt; t += 2) { \
            const bool last = (t == nt - 2); \
            const char* a1 = cA + (size_t)(t + 1) * kstep; \
            const char* a2 = last ? nA : cA + (size_t)(t + 2) * kstep; const char* b2 = last ? nB : cB + (size_t)(t + 2) * kstep; \
            const char* a3 = a2 + kstep; const char* b3 = b2 + kstep; \
              \
            PG8_LDB(B0, 0, 0); PG8_LDB(B1, 0, 1); PG8_SCHED; PG8_LDA(At, 0, 0); PG8_STAGE_A(PG8_SA(1, 1), a1, 1, false); \
            PG8_WAIT_V(8); PG8_WAIT_L(0); PG8_BAR; MMF(0, 0, At, B0); MMF(0, 1, At, B1); PG8_BAR; PG8_SCHED; \
              \
            PG8_LDA(At, 0, 1); PG8_STAGE(PG8_SB(0, 0), b2, voffB); PG8_STAGE(PG8_SB(0, 1), b2 + hstepB, voffB); PG8_STAGE_A(PG8_SA(0, 0), a2, 0, last); \
            PG8_WAIT_V(8); PG8_WAIT_L(0); PG8_BAR; MMF(1, 0, At, B0); MMF(1, 1, At, B1); PG8_BAR; PG8_SCHED; \
              \
            PG8_LDB(B0, 1, 0); PG8_LDB(B1, 1, 1); PG8_SCHED; PG8_LDA(At, 1, 0); PG8_STAGE_A(PG8_SA(0, 1), a2, 1, last); \
            PG8_WAIT_V(8); PG8_WAIT_L(0); PG8_BAR; MMF(0, 0, At, B0); MMF(0, 1, At, B1); PG8_BAR; PG8_SCHED; \
              \
            PG8_LDA(At, 1, 1); PG8_STAGE(PG8_SB(1, 0), b3, voffB); PG8_STAGE(PG8_SB(1, 1), b3 + hstepB, voffB); PG8_STAGE_A(PG8_SA(1, 0), a3, 0, last); \
            PG8_WAIT_V(8); PG8_WAIT_L(0); PG8_BAR; MMF(1, 0, At, B0); MMF(1, 1, At, B1); PG8_BAR; PG8_SCHED; \
        }
        if constexpr (MIXED) { if (f8u) { PG8_KLOOP(PG8_MMA_F8) } else { PG8_KLOOP(PG8_MMA_BF) } }
        else if constexpr (FP8) { PG8_KLOOP(PG8_MMA_F8) } else { PG8_KLOOP(PG8_MMA_BF) }
#undef PG8_KLOOP
        if (wr == 0) PG8_BAR;
#define PG8_ACC8(a_, b_) "+v"(acc[a_][b_][0][0]), "+v"(acc[a_][b_][0][1]), "+v"(acc[a_][b_][1][0]), "+v"(acc[a_][b_][1][1]), "+v"(acc[a_][b_][2][0]), "+v"(acc[a_][b_][2][1]), "+v"(acc[a_][b_][3][0]), "+v"(acc[a_][b_][3][1])
        asm volatile("s_nop 15\n\ts_nop 15" : PG8_ACC8(0, 0), PG8_ACC8(0, 1) :: "memory");
        asm volatile("" : PG8_ACC8(1, 0), PG8_ACC8(1, 1) :: "memory");
#undef PG8_ACC8
        { int fr_ = fr, fq_ = fq; asm volatile("" : "+v"(fr_), "+v"(fq_));
          E(acc, cur, wr, wc, fr_, fq_); }
        if (!has_next) break;
#pragma unroll
        for (int a = 0; a < 2; ++a)
#pragma unroll
            for (int b = 0; b < 2; ++b)
#pragma unroll
                for (int m = 0; m < 4; ++m)
#pragma unroll
                    for (int n = 0; n < 2; ++n) acc[a][b][m][n] = (f32x4){0.f, 0.f, 0.f, 0.f};
        cur = nxt; cA = nA; cB = nB; ++ui;
        if constexpr (GATHER) {
#pragma unroll
            for (int h = 0; h < 2; ++h)
#pragma unroll
                for (int i = 0; i < 2; ++i) gC[h][i] = gN[h][i];
        }
        if (wr == 1) PG8_BAR;
    }
    PG8_WAIT_V(0);
    PG8_BAR;
#undef PG8_SA
#undef PG8_SB
#undef PG8_STAGE
#undef PG8_STAGE_A
#undef PG8_LDA
#undef PG8_LDB
#undef PG8_MMA_F8
#undef PG8_MMA_BF
#undef PG8_WAIT_V
#undef PG8_WAIT_L
#undef PG8_BAR
#undef PG8_SCHED
}
}
typedef f32x4 AccT[2][2][4][2];

struct Frame {
    LAS unsigned char* lds;
    volatile LAS unsigned* MISC;
    unsigned* ctl;
    unsigned char* ws;
    float* out;
    int tid, lane, wave, vcu, G;
    int hm_tiles;
};
enum { IN_X = 0, IN_C, IN_CTX, IN_CCTX, IN_WMOD, IN_BMOD, IN_GPREMIX, IN_GPOSTMIX, IN_GPREFFN, IN_GPOSTFFN, IN_WIN, IN_GQ, IN_WUQ, IN_GKV, IN_WUKV, IN_RPB,
       IN_GV, IN_BV, IN_WSP, IN_BSP, IN_WBR, IN_WOUT, IN_WFFN1, IN_WFFN3, IN_WFFN2, IN_WROUTER, IN_WMOE1, IN_WMOE3, IN_WMOE2 };
constexpr int MI_CNT = 16, MI_TB = 24, MI_IN = 64;

__device__ __forceinline__ bf16_t* wsb(const Frame& F, size_t off) { return (bf16_t*)(F.ws + off); }
__device__ __forceinline__ const float* inp(const Frame& F, int i) {
    const unsigned lo = F.MISC[MI_IN + 2 * i], hi = F.MISC[MI_IN + 2 * i + 1];
    return (const float*)(((unsigned long long)(unsigned)__builtin_amdgcn_readfirstlane((int)hi) << 32) | (unsigned long long)(unsigned)__builtin_amdgcn_readfirstlane((int)lo));
}
__device__ __forceinline__ bf16_t* layer_w(const Frame& F, int l, size_t off) { return (bf16_t*)(F.ws + WS_W0 + (size_t)l * SZ_LAYERW + off); }

__device__ __forceinline__ void static_tile(int L, int nM, int nN, int& pm, int& pn) {
    const int nwg = nM * nN; int wgid = L;
    { const int q = nwg / 8, r = nwg % 8, xcd = wgid % 8, off = wgid / 8; wgid = (xcd < r ? xcd * (q + 1) : r * (q + 1) + (xcd - r) * q) + off; }
    const int nig = 8 * nN, gid = wgid / nig, fm = gid * 8, gsz = (nM - fm) < 8 ? (nM - fm) : 8;
    const int w = wgid % nig;
    if (gsz == 8) { pm = fm + (w & 7); pn = w >> 3; } else { pm = fm + (w % gsz); pn = w / gsz; }
}
__device__ __forceinline__ u32x4 pack8(const f32x4 a, const f32x4 b) { u32x4 w; w.x = pk2(a[0], a[1]); w.y = pk2(a[2], a[3]); w.z = pk2(b[0], b[1]); w.w = pk2(b[2], b[3]); return w; }
__device__ __forceinline__ void row_b_pos(int r, int& b, int& pos, bool& latent) {
    if (r < MX) { b = r >> 12; pos = CTX + (r & 4095); latent = true; } else { const int rc = r - MX; b = rc >> 8; pos = rc & 255; latent = false; }
}

struct SchedPlain {
    const char* A; const char* B; int lda2, ldb2, nt, nM, nN, G, c;
    __device__ __forceinline__ bool next(int i, pg8::Unit& u) const {
        const int L = i * G + c; if (L >= nM * nN) return false;
        int pm, pn; static_tile(L, nM, nN, pm, pn);
        u.A = A + (size_t)pm * 256 * lda2; u.B = B + (size_t)pn * 256 * ldb2; u.nt = nt; u.job = 0; u.pm = pm; u.pn = pn; return true;
    }
};
struct EpiPlain {
    bf16_t* O; int ld;
    __device__ __forceinline__ void operator()(const AccT& acc, const pg8::Unit& u, int wr, int wc, int fr, int fq) const {
#pragma unroll
        for (int ai = 0; ai < 2; ++ai)
#pragma unroll
            for (int m = 0; m < 4; ++m) { bf16_t* rowp = O + (size_t)(u.pm * 256 + ai * 128 + wr * 64 + m * 16 + fr) * ld + u.pn * 256 + wc * 32 + fq * 8;
#pragma unroll
                for (int bj = 0; bj < 2; ++bj) *(u32x4*)(rowp + bj * 128) = pack8(acc[ai][bj][m][0], acc[ai][bj][m][1]); }
    }
};

struct SchedG1 {
    const char* N; const char* W; int G, c, layer;
    __device__ __forceinline__ bool next(int i, pg8::Unit& u) const {
        int L = i * G + c; u.nt = 16;
        if (L < 896) { int pm, pn; static_tile(L, 128, 7, pm, pn); u.A = N + (size_t)pm * 256 * 2048; u.B = W + (size_t)pn * 256 * 2048; u.job = 0; u.pm = pm; u.pn = pn; return true; }
        L -= 896;
        if (L < 128) { u.A = W + (size_t)1792 * 2048; u.B = N + (size_t)L * 256 * 2048; u.job = 1; u.pm = 0; u.pn = L; return true; }
        L -= 128;
        if (layer == 0) {
            if (L < 56) { const int pm = 128 + L / 7, pn = L % 7; u.A = N + (size_t)pm * 256 * 2048; u.B = W + (size_t)pn * 256 * 2048; u.job = 0; u.pm = pm; u.pn = pn; return true; }
            L -= 56;
        } else {
            if (L < 24) { const int pm = 128 + L / 3, q = L % 3, pn = (q == 0) ? 0 : (q == 1 ? 2 : 6); u.A = N + (size_t)pm * 256 * 2048; u.B = W + (size_t)pn * 256 * 2048; u.job = 0; u.pm = pm; u.pn = pn; return true; }
            L -= 24;
        }
        if (L < 8) { u.A = W + (size_t)1792 * 2048; u.B = N + (size_t)(128 + L) * 256 * 2048; u.job = 1; u.pm = 0; u.pn = 128 + L; return true; }
        return false;
    }
};
__device__ __forceinline__ void rope8(f32x4& v0, f32x4& v1, int fq, int s, const float* TAB) {
    const int p = (fq < 2) ? (s >> 6) : (s & 63);
    const f32x4* t = (const f32x4*)(TAB + p * 16);
    const f32x4 t0 = t[0], t1 = t[1], t2 = t[2], t3 = t[3];
    f32x4 p0, p1;
#pragma unroll
    for (int j = 0; j < 4; ++j) { p0[j] = __shfl_xor(v0[j], 16); p1[j] = __shfl_xor(v1[j], 16); }
    const float sg = (fq & 1) ? 1.0f : -1.0f;
    v0[0] = v0[0] * t0[0] + sg * p0[0] * t0[1]; v0[1] = v0[1] * t0[2] + sg * p0[1] * t0[3];
    v0[2] = v0[2] * t1[0] + sg * p0[2] * t1[1]; v0[3] = v0[3] * t1[2] + sg * p0[3] * t1[3];
    v1[0] = v1[0] * t2[0] + sg * p1[0] * t2[1]; v1[1] = v1[1] * t2[2] + sg * p1[1] * t2[3];
    v1[2] = v1[2] * t3[0] + sg * p1[2] * t3[1]; v1[3] = v1[3] * t3[2] + sg * p1[3] * t3[3];
}
struct EpiG1 {
    bf16_t *CKV, *NAQ, *NAK, *U, *V, *CQ, *K, *NAVT; float* SSQ; const float* TAB;
    __device__ __forceinline__ void operator()(const AccT& acc, const pg8::Unit& u, int wr, int wc, int fr, int fq) const {
        if (u.job == 1) {
            const int tn = u.pn; int b, pos0; if (tn < 128) { b = tn >> 4; pos0 = CTX + (tn & 15) * 256; } else { b = tn - 128; pos0 = 0; }
#pragma unroll
            for (int ai = 0; ai < 2; ++ai)
#pragma unroll
                for (int m = 0; m < 4; ++m) { const int f = ai * 128 + wr * 64 + m * 16 + fr;
                    bf16_t* rowp = NAVT + ((size_t)(b * 256 + f) * LK + pos0) + wc * 32 + fq * 8;
#pragma unroll
                    for (int bj = 0; bj < 2; ++bj) *(u32x4*)(rowp + bj * 128) = pack8(acc[ai][bj][m][0], acc[ai][bj][m][1]); }
            return;
        }
        const int pn = u.pn; const int row0 = u.pm * 256 + wr * 64 + fr;
        if (pn >= 1 && pn <= 4) {
            bf16_t* dst = (pn == 1) ? NAQ : (pn == 2) ? NAK : (pn == 3) ? U : V; const float sc = (pn == 1) ? 0.125f * LOG2E : 1.0f;
#pragma unroll
            for (int ai = 0; ai < 2; ++ai)
#pragma unroll
                for (int m = 0; m < 4; ++m) { bf16_t* rowp = dst + (size_t)(row0 + ai * 128 + m * 16) * 256 + wc * 32 + fq * 8;
#pragma unroll
                    for (int bj = 0; bj < 2; ++bj) *(u32x4*)(rowp + bj * 128) = pack8(acc[ai][bj][m][0] * sc, acc[ai][bj][m][1] * sc); }
            return;
        }
        if (pn == 0 || pn == 5) {
            bf16_t* dst = (pn == 0) ? CKV : CQ; const int ld = (pn == 0) ? 256 : 384; const int slot = (pn == 0) ? 0 : 4;
#pragma unroll
            for (int ai = 0; ai < 2; ++ai)
#pragma unroll
                for (int m = 0; m < 4; ++m) { const int r = row0 + ai * 128 + m * 16; bf16_t* rowp = dst + (size_t)r * ld + wc * 32 + fq * 8; float s = 0.f;
#pragma unroll
                    for (int bj = 0; bj < 2; ++bj) { const f32x4 a = acc[ai][bj][m][0], b = acc[ai][bj][m][1]; *(u32x4*)(rowp + bj * 128) = pack8(a, b);
                        s += (a[0] * a[0] + a[1] * a[1]) + (a[2] * a[2] + a[3] * a[3]) + (b[0] * b[0] + b[1] * b[1]) + (b[2] * b[2] + b[3] * b[3]); }
                    s += __shfl_xor(s, 16); s += __shfl_xor(s, 32);
                    if (fq == 0) SSQ[(size_t)r * 12 + slot + wc] = s; }
            return;
        }
#pragma unroll
        for (int ai = 0; ai < 2; ++ai)
#pragma unroll
            for (int m = 0; m < 4; ++m) { const int r = row0 + ai * 128 + m * 16;
                { const f32x4 a = acc[ai][0][m][0], b = acc[ai][0][m][1]; *(u32x4*)(CQ + (size_t)r * 384 + 256 + wc * 32 + fq * 8) = pack8(a, b);
                  float s = (a[0] * a[0] + a[1] * a[1]) + (a[2] * a[2] + a[3] * a[3]) + (b[0] * b[0] + b[1] * b[1]) + (b[2] * b[2] + b[3] * b[3]);
                  s += __shfl_xor(s, 16); s += __shfl_xor(s, 32);
                  if (fq == 0) SSQ[(size_t)r * 12 + 8 + wc] = s; }
                if (wc == 0) { f32x4 a = acc[ai][1][m][0], b = acc[ai][1][m][1]; int bb, pos; bool lat; row_b_pos(r, bb, pos, lat);
                    if (lat) rope8(a, b, fq, r & 4095, TAB);
                    const u32x4 w = pack8(a, b); bf16_t* kp = K + ((size_t)(bb * 8) * LK + pos) * 96 + 64 + fq * 8;
#pragma unroll
                    for (int h = 0; h < 8; ++h) *(u32x4*)(kp + (size_t)h * LK * 96) = w; } }
    }
};

struct EpiG2Q {
    bf16_t* Q; const float* SSQ; const float* TAB;
    __device__ __forceinline__ void operator()(const AccT& acc, const pg8::Unit& u, int wr, int wc, int fr, int fq) const {
        const int row0 = u.pm * 256 + wr * 64 + fr; const float QS = 0.10206207261596575f * LOG2E;
#pragma unroll
        for (int ai = 0; ai < 2; ++ai)
#pragma unroll
            for (int m = 0; m < 4; ++m) { const int r = row0 + ai * 128 + m * 16;
                const f32x4 s0 = *(const f32x4*)(SSQ + (size_t)r * 12 + 4), s1 = *(const f32x4*)(SSQ + (size_t)r * 12 + 8);
                const float ss = ((s0[0] + s0[1]) + (s0[2] + s0[3])) + ((s1[0] + s1[1]) + (s1[2] + s1[3]));
                const float sc = QS * __builtin_amdgcn_rsqf(ss * (1.0f / 384.0f) + EPS);
#pragma unroll
                for (int bj = 0; bj < 2; ++bj) { f32x4 a = acc[ai][bj][m][0] * sc, b = acc[ai][bj][m][1] * sc;
                    if (u.pn < 2) { const int c = u.pn * 256 + bj * 128 + wc * 32 + fq * 8; *(u32x4*)(Q + (size_t)r * 768 + (c >> 6) * 96 + (c & 63)) = pack8(a, b); }
                    else { if (r < MX) rope8(a, b, fq, r & 4095, TAB); *(u32x4*)(Q + (size_t)r * 768 + (bj * 4 + wc) * 96 + 64 + fq * 8) = pack8(a, b); } } asm volatile("" ::: "memory"); }
    }
};
struct SchedG2KV {
    const char* CKV; const char* W; int G, c;
    __device__ __forceinline__ bool next(int i, pg8::Unit& u) const {
        int L = i * G + c; u.nt = 4;
        if (L < 272) { int pm, pn; static_tile(L, 136, 2, pm, pn); u.A = CKV + (size_t)pm * 256 * 512; u.B = W + (size_t)pn * 256 * 512; u.job = 0; u.pm = pm; u.pn = pn; return true; }
        L -= 272;
        if (L < 272) { int pn, pm; static_tile(L, 136, 2, pn, pm); u.A = W + (size_t)(512 + pm * 256) * 512; u.B = CKV + (size_t)pn * 256 * 512; u.job = 1; u.pm = pm; u.pn = pn; return true; }
        return false;
    }
};
struct EpiG2KV {
    bf16_t *K, *VT; const float* SSQ;
    __device__ __forceinline__ void operator()(const AccT& acc, const pg8::Unit& u, int wr, int wc, int fr, int fq) const {
        if (u.job == 0) {
            const int row0 = u.pm * 256 + wr * 64 + fr;
#pragma unroll
            for (int ai = 0; ai < 2; ++ai)
#pragma unroll
                for (int m = 0; m < 4; ++m) { const int r = row0 + ai * 128 + m * 16; const f32x4 s0 = *(const f32x4*)(SSQ + (size_t)r * 12);
                    const float sc = __builtin_amdgcn_rsqf(((s0[0] + s0[1]) + (s0[2] + s0[3])) * (1.0f / 256.0f) + EPS);
                    int bb, pos; bool lat; row_b_pos(r, bb, pos, lat);
#pragma unroll
                    for (int bj = 0; bj < 2; ++bj) { const int c = u.pn * 256 + bj * 128 + wc * 32 + fq * 8;
                        *(u32x4*)(K + ((size_t)(bb * 8 + (c >> 6)) * LK + pos) * 96 + (c & 63)) = pack8(acc[ai][bj][m][0] * sc, acc[ai][bj][m][1] * sc); } asm volatile("" ::: "memory"); }
            return;
        }
        const int tn = u.pn; int b, pos0; if (tn < 128) { b = tn >> 4; pos0 = CTX + (tn & 15) * 256; } else { b = tn - 128; pos0 = 0; }
#pragma unroll
        for (int bj = 0; bj < 2; ++bj) { f32x4 sc0, sc1;
#pragma unroll
            for (int j = 0; j < 8; ++j) { const int t = tn * 256 + bj * 128 + wc * 32 + fq * 8 + j; const f32x4 s0 = *(const f32x4*)(SSQ + (size_t)t * 12);
                const float v = __builtin_amdgcn_rsqf(((s0[0] + s0[1]) + (s0[2] + s0[3])) * (1.0f / 256.0f) + EPS); if (j < 4) sc0[j & 3] = v; else sc1[j & 3] = v;
                if ((j & 3) == 3) asm volatile("" ::: "memory"); }
#pragma unroll
            for (int ai = 0; ai < 2; ++ai)
#pragma unroll
                for (int m = 0; m < 4; ++m) { const int f = u.pm * 256 + ai * 128 + wr * 64 + m * 16 + fr;
                    bf16_t* rowp = VT + ((size_t)(b * 512 + f) * LK + pos0) + wc * 32 + fq * 8;
                    *(u32x4*)(rowp + bj * 128) = pack8(acc[ai][bj][m][0] * sc0, acc[ai][bj][m][1] * sc1); }
            asm volatile("" ::: "memory"); }
    }
};

struct SchedG3 {
    const char* N; const char* Y; const char* WGL; const char* WBR; int nctx, G, c, f8g;
    __device__ __forceinline__ bool next(int i, pg8::Unit& u) const {
        const int nx = (512 - c + G - 1) / G;
        if (i >= 6 * nx) { const int j = i - 6 * nx, p = c + (j >> 1) * G; if (p >= nctx * 3) return false;
            const int T = p / 3, g = p - T * 3, pm = 128 + (T >> 2), pn = T & 3; u.pm = pm; u.pn = pn;
            if ((j & 1) == 0) { u.job = 8 + 2 * g; u.A = N + (size_t)pm * 256 * 2048; u.B = WGL + (size_t)(g * 1024 + pn * 256) * 2048; u.nt = f8g ? 8 : 16; u.f8 = f8g; }
            else { const int koff = (g == 0) ? 0 : (g == 1 ? 512 : 768); u.job = 8 + 2 * g + 1; u.A = Y + (size_t)pm * 256 * 2048 + koff * 2; u.B = WBR + (size_t)pn * 256 * 2048 + koff * 2; u.nt = (g == 0) ? 8 : 4; u.f8 = 0; }
            return true; }
        const int ti = i / 6, sub = i - ti * 6; const int L = ti * G + c;
        int pm, pn; static_tile(L, 128, 4, pm, pn); const int g = sub >> 1; u.job = sub; u.pm = pm; u.pn = pn;
        if ((sub & 1) == 0) { u.A = N + (size_t)pm * 256 * 2048; u.B = WGL + (size_t)(g * 1024 + pn * 256) * 2048; u.nt = f8g ? 8 : 16; u.f8 = f8g; }
        else { const int koff = (g == 0) ? 0 : (g == 1 ? 512 : 768); u.A = Y + (size_t)pm * 256 * 2048 + koff * 2; u.B = WBR + (size_t)pn * 256 * 2048 + koff * 2; u.nt = (g == 0) ? 8 : 4; u.f8 = 0; }
        return true;
    }
};
struct EpiG3 {
    bf16_t* Z; unsigned char* scr; bf16_t* ZP; float gsc;
    __device__ __forceinline__ void operator()(const AccT& acc, const pg8::Unit& u, int wr, int wc, int fr, int fq) const {
        const int sub = u.job & 7; const bool ctxp = (u.job & 8) != 0;
        const int tid_ = (wr * 4 + wc) * 64 + fq * 16 + fr; u32x4* gs = (u32x4*)scr + tid_; u32x4* zs = (u32x4*)(scr + 131072) + tid_;
        if ((sub & 1) == 0) {
#pragma unroll
            for (int ai = 0; ai < 2; ++ai)
#pragma unroll
                for (int bj = 0; bj < 2; ++bj)
#pragma unroll
                    for (int m = 0; m < 4; ++m) { f32x4 a = acc[ai][bj][m][0], b = acc[ai][bj][m][1];
#pragma unroll
                        for (int j = 0; j < 4; ++j) { a[j] = sigmoidf_(a[j] * gsc); b[j] = sigmoidf_(b[j] * gsc); }
                        gs[((ai * 2 + bj) * 4 + m) * 512] = pack8(a, b); asm volatile("" ::: "memory"); }
            return;
        }
#pragma unroll
        for (int ai = 0; ai < 2; ++ai)
#pragma unroll
            for (int mh = 0; mh < 2; ++mh) { u32x4 gq[4], zq[4];
#pragma unroll
                for (int q = 0; q < 4; ++q) { const int idx = ((ai * 2 + (q & 1)) * 4 + mh * 2 + (q >> 1)) * 512; gq[q] = gs[idx]; zq[q] = zs[idx]; }
#pragma unroll
                for (int q = 0; q < 4; ++q) { const int bj = q & 1, m = mh * 2 + (q >> 1), idx = ((ai * 2 + bj) * 4 + m) * 512; const u32x4 g = gq[q];
                    f32x4 a = acc[ai][bj][m][0], b = acc[ai][bj][m][1];
                    a[0] *= bf_lo(g.x); a[1] *= bf_hi(g.x); a[2] *= bf_lo(g.y); a[3] *= bf_hi(g.y); b[0] *= bf_lo(g.z); b[1] *= bf_hi(g.z); b[2] *= bf_lo(g.w); b[3] *= bf_hi(g.w);
                    if (sub > 1 && !ctxp) { const u32x4 z = zq[q]; a[0] += bf_lo(z.x); a[1] += bf_hi(z.x); a[2] += bf_lo(z.y); a[3] += bf_hi(z.y); b[0] += bf_lo(z.z); b[1] += bf_hi(z.z); b[2] += bf_lo(z.w); b[3] += bf_hi(z.w); }
                    const u32x4 w = pack8(a, b);
                    if (ctxp) *(u32x4*)(ZP + ((size_t)(sub >> 1) * MC + (u.pm - 128) * 256 + ai * 128 + wr * 64 + m * 16 + fr) * 1024 + u.pn * 256 + wc * 32 + fq * 8 + bj * 128) = w;
                    else if (sub == 5) *(u32x4*)(Z + (size_t)(u.pm * 256 + ai * 128 + wr * 64 + m * 16 + fr) * 1024 + u.pn * 256 + wc * 32 + fq * 8 + bj * 128) = w; else zs[idx] = w; }
                asm volatile("" ::: "memory"); }
    }
};

__device__ __forceinline__ float silu_mul(float g, float u) { return g * sigmoidf_(g) * u; }
struct EpiSwiglu {
    bf16_t* H; int ld; int pm_off;
    __device__ __forceinline__ void operator()(const AccT& acc, const pg8::Unit& u, int wr, int wc, int fr, int fq) const {
#pragma unroll
        for (int ai = 0; ai < 2; ++ai)
#pragma unroll
            for (int m = 0; m < 4; ++m) { bf16_t* rowp = H + (size_t)((u.pm - pm_off) * 256 + ai * 128 + wr * 64 + m * 16 + fr) * ld + u.pn * 128 + wc * 32 + fq * 8;
                f32x4 a, b;
                { const f32x4 g0 = acc[ai][0][m][0], g1 = acc[ai][0][m][1]; f32x4 e0 = g0 * (-LOG2E), e1 = g1 * (-LOG2E);
#pragma unroll
                  for (int j = 0; j < 4; ++j) { e0[j] = fast_exp2(e0[j]); e1[j] = fast_exp2(e1[j]); }
                  e0 = e0 + 1.0f; e1 = e1 + 1.0f;
#pragma unroll
                  for (int j = 0; j < 4; ++j) { e0[j] = __builtin_amdgcn_rcpf(e0[j]); e1[j] = __builtin_amdgcn_rcpf(e1[j]); }
                  a = (g0 * acc[ai][1][m][0]) * e0; b = (g1 * acc[ai][1][m][1]) * e1; }
                *(u32x4*)rowp = pack8(a, b); }
    }
};
struct EpiSwigluS {
    bf16_t* H; int ld; int pm_off;
    __device__ __forceinline__ void operator()(const AccT& acc, const pg8::Unit& u, int wr, int wc, int fr, int fq) const {
#pragma unroll
        for (int ai = 0; ai < 2; ++ai)
#pragma unroll
            for (int m = 0; m < 4; ++m) { bf16_t* rowp = H + (size_t)((u.pm - pm_off) * 256 + ai * 128 + wr * 64 + m * 16 + fr) * ld + u.pn * 128 + wc * 32 + fq * 8;
                f32x4 a, b;
                { const f32x4 g0 = acc[ai][0][m][0], g1 = acc[ai][0][m][1]; f32x4 e0 = g0 * (-LOG2E * 0.03125f) + 10.0f, e1 = g1 * (-LOG2E * 0.03125f) + 10.0f;
#pragma unroll
                  for (int j = 0; j < 4; ++j) { e0[j] = fast_exp2(e0[j]); e1[j] = fast_exp2(e1[j]); }
                  e0 = e0 + 1024.0f; e1 = e1 + 1024.0f;
#pragma unroll
                  for (int j = 0; j < 4; ++j) { e0[j] = __builtin_amdgcn_rcpf(e0[j]); e1[j] = __builtin_amdgcn_rcpf(e1[j]); }
                  a = (g0 * acc[ai][1][m][0]) * e0; b = (g1 * acc[ai][1][m][1]) * e1; }
                *(u32x4*)rowp = pack8(a, b); }
    }
};
struct EpiSwigluF8 {
    unsigned char* H; int ld; int pm_off;
    __device__ __forceinline__ void operator()(const AccT& acc, const pg8::Unit& u, int wr, int wc, int fr, int fq) const {
#pragma unroll
        for (int ai = 0; ai < 2; ++ai)
#pragma unroll
            for (int m = 0; m < 4; ++m) { unsigned char* rowp = H + (size_t)((u.pm - pm_off) * 256 + ai * 128 + wr * 64 + m * 16 + fr) * ld + u.pn * 128 + wc * 32 + fq * 8;
                f32x4 a, b;
                { const f32x4 g0 = acc[ai][0][m][0], g1 = acc[ai][0][m][1]; f32x4 e0 = g0 * (-LOG2E * 0.03125f) + 10.0f, e1 = g1 * (-LOG2E * 0.03125f) + 10.0f;
#pragma unroll
                  for (int j = 0; j < 4; ++j) { e0[j] = fast_exp2(e0[j]); e1[j] = fast_exp2(e1[j]); }
                  e0 = e0 + 1024.0f; e1 = e1 + 1024.0f;
#pragma unroll
                  for (int j = 0; j < 4; ++j) { e0[j] = __builtin_amdgcn_rcpf(e0[j]); e1[j] = __builtin_amdgcn_rcpf(e1[j]); }
                  a = (g0 * acc[ai][1][m][0]) * e0; b = (g1 * acc[ai][1][m][1]) * e1;
#pragma unroll
                  for (int j = 0; j < 4; ++j) { a[j] = __builtin_amdgcn_fmed3f(a[j], -440.0f, 440.0f); b[j] = __builtin_amdgcn_fmed3f(b[j], -440.0f, 440.0f); } }
                u32x2 w; w.x = (unsigned)pk4_fp8(a[0], a[1], a[2], a[3]); w.y = (unsigned)pk4_fp8(b[0], b[1], b[2], b[3]); *(u32x2*)rowp = w; }
    }
};
struct SchedMoeUp {
    const char* XG; const char* W; volatile LAS unsigned* MISC; int t_lo, t_hi, G, c; int tb[7];
    int nx;
    __device__ __forceinline__ bool next(int i, pg8::Unit& u) const {
        int L = i * G + c;
        if (nx > 0) { if (c < nx) { if (i >= 11) return false; }
                      else if (c < 4 * nx && i >= 14) { if (i > 14) return false; const int j = c - nx; L = (11 + j / nx) * G + (j % nx); } }
        const int nM = t_hi - t_lo; if (L >= nM * 28) return false;
        int pm, pn; static_tile(L, nM, 28, pm, pn); const int gt = t_lo + pm; int e = 0;
#pragma unroll
        for (int j = 0; j < 7; ++j) e += (tb[j] <= gt) ? 1 : 0;
        u.A = XG + (size_t)gt * 256 * 1024; u.B = W + (size_t)(e * 7168 + pn * 256) * 1024; u.nt = 8; u.job = e; u.pm = gt; u.pn = pn; return true;
    }
};
struct SchedMoeDown {
    const char* HM; const char* W; volatile LAS unsigned* MISC; int t_lo, t_hi, G, c; int tb[7];
    __device__ __forceinline__ bool next(int i, pg8::Unit& u) const {
        const int L = i * G + c; const int nM = t_hi - t_lo; if (L >= nM * 4) return false;
        int pm, pn; static_tile(L, nM, 4, pm, pn); const int gt = t_lo + pm; int e = 0;
#pragma unroll
        for (int j = 0; j < 7; ++j) e += (tb[j] <= gt) ? 1 : 0;
        u.A = HM + (size_t)pm * 256 * 3584; u.B = W + (size_t)(e * 1024 + pn * 256) * 3584; u.nt = 28; u.job = e; u.pm = gt; u.pn = pn; return true;
    }
};
struct EpiMoeDown {
    bf16_t* Y2; const int* LTOK; const float* LW; volatile LAS unsigned* MISC;
    __device__ __forceinline__ void operator()(const AccT& acc, const pg8::Unit& u, int wr, int wc, int fr, int fq) const {
        const int e = u.job; const int pos0 = (u.pm - (int)MISC[MI_TB + e]) * 256 + wr * 64 + fr; const int cnt = (int)MISC[MI_CNT + e];
#pragma unroll
        for (int ai = 0; ai < 2; ++ai)
#pragma unroll
            for (int m = 0; m < 4; ++m) { const int pos = pos0 + ai * 128 + m * 16;
                if (pos < cnt) { const int tk = LTOK[e * 32768 + pos]; const float w = LW[e * 32768 + pos] * 0.015625f;
                    bf16_t* rowp = Y2 + (size_t)tk * 1024 + u.pn * 256 + wc * 32 + fq * 8;
#pragma unroll
                    for (int bj = 0; bj < 2; ++bj) *(u32x4*)(rowp + bj * 128) = pack8(acc[ai][bj][m][0] * w, acc[ai][bj][m][1] * w); } asm volatile("" ::: "memory"); }
    }
};

__device__ __forceinline__ void ld_f32(const float* p, int lane, f32x4 (&v)[4]) { const f32x4* q = (const f32x4*)p + lane;
#pragma unroll
    for (int j = 0; j < 4; ++j) v[j] = q[64 * j]; }
__device__ __forceinline__ void st_f32(float* p, int lane, const f32x4 (&v)[4]) { f32x4* q = (f32x4*)p + lane;
#pragma unroll
    for (int j = 0; j < 4; ++j) q[64 * j] = v[j]; }
__device__ __forceinline__ void ld_bf16(const bf16_t* p, int lane, f32x4 (&v)[4]) { const u32x2* q = (const u32x2*)p + lane;
#pragma unroll
    for (int j = 0; j < 4; ++j) { const u32x2 w = q[64 * j]; v[j] = (f32x4){bf_lo(w.x), bf_hi(w.x), bf_lo(w.y), bf_hi(w.y)}; } }
__device__ __forceinline__ void ld_raw(const bf16_t* p, int lane, u32x2 (&w)[4]) { const u32x2* q = (const u32x2*)p + lane;
#pragma unroll
    for (int j = 0; j < 4; ++j) w[j] = q[64 * j]; }
__device__ __forceinline__ void cvt_raw(const u32x2 (&w)[4], f32x4 (&v)[4]) {
#pragma unroll
    for (int j = 0; j < 4; ++j) v[j] = (f32x4){bf_lo(w[j].x), bf_hi(w[j].x), bf_lo(w[j].y), bf_hi(w[j].y)}; }
__device__ __forceinline__ void cp4(f32x4 (&d)[4], const f32x4 (&s)[4]) { d[0] = s[0]; d[1] = s[1]; d[2] = s[2]; d[3] = s[3]; }
__device__ __forceinline__ void cp4(u32x2 (&d)[4], const u32x2 (&s)[4]) { d[0] = s[0]; d[1] = s[1]; d[2] = s[2]; d[3] = s[3]; }
__device__ __forceinline__ void st_bf16(bf16_t* p, int lane, const f32x4 (&v)[4]) { u32x2* q = (u32x2*)p + lane;
#pragma unroll
    for (int j = 0; j < 4; ++j) { u32x2 w; w.x = pk2(v[j][0], v[j][1]); w.y = pk2(v[j][2], v[j][3]); q[64 * j] = w; } }
__device__ __forceinline__ float row_rstd(const f32x4 (&v)[4]) { float s = 0.f;
#pragma unroll
    for (int j = 0; j < 4; ++j) s += (v[j][0] * v[j][0] + v[j][1] * v[j][1]) + (v[j][2] * v[j][2] + v[j][3] * v[j][3]);
    return __builtin_amdgcn_rsqf(wave_sum(s) * (1.0f / 1024.0f) + EPS); }
__device__ __forceinline__ const float* modp(const Frame& F, int l, int v, int i) { return (const float*)(F.ctl + CW_MOD) + ((size_t)(l * 9 + v) * 6144 + i * 1024); }

__device__ __forceinline__ void make_affine(const Frame& F, const float* g, const float* mscale, const float* mshift, f32x4 (&A)[4], f32x4 (&B)[4]) {
    f32x4 gg[4], ms[4]; ld_f32(g, F.lane, gg); ld_f32(mscale, F.lane, ms); ld_f32(mshift, F.lane, B);
#pragma unroll
    for (int j = 0; j < 4; ++j) A[j] = gg[j] * (ms[j] + 1.0f);
}
__device__ __forceinline__ void make_gate(const Frame& F, const float* g, const float* mgate, f32x4 (&P)[4]) {
    f32x4 gg[4], mg[4]; ld_f32(g, F.lane, gg); ld_f32(mgate, F.lane, mg);
#pragma unroll
    for (int j = 0; j < 4; ++j) P[j] = gg[j] * mg[j];
}

__device__ __forceinline__ void st_n8(float* out, size_t row, int lane, const f32x4 (&v)[4]) {
    int* q = (int*)((unsigned char*)out + row * 2048) + lane;
#pragma unroll
    for (int j = 0; j < 4; ++j) q[64 * j] = pk4_fp8(clamp8(v[j][0]), clamp8(v[j][1]), clamp8(v[j][2]), clamp8(v[j][3])); }
__device__ __forceinline__ void phase_T0(const Frame& F) {
    const int gw = F.vcu * NWAVES + F.wave, NGW = F.G * NWAVES; bf16_t* N = wsb(F, WS_N);
    for (int ch = gw; ch < 2048; ch += NGW) { const int b = ch >> 8; f32x4 A[4], B[4]; make_affine(F, inp(F, IN_GPREMIX), modp(F, 0, b, 1), modp(F, 0, b, 0), A, B);
        const float* X = inp(F, IN_X); f32x4 hn[4]; ld_f32(X + (size_t)ch * 16 * 1024, F.lane, hn);
        for (int rr = 0; rr < 16; ++rr) { const size_t r = (size_t)ch * 16 + rr; f32x4 h[4]; cp4(h, hn); if (rr < 15) ld_f32(X + (r + 1) * 1024, F.lane, hn); const float rs = row_rstd(h);
#pragma unroll
            for (int j = 0; j < 4; ++j) h[j] = h[j] * rs * A[j] + B[j];
            st_bf16(N + r * 1024, F.lane, h); st_n8(F.out, r, F.lane, h); } }
    { f32x4 A[4], B[4]; make_affine(F, inp(F, IN_GPREMIX), modp(F, 0, 8, 1), modp(F, 0, 8, 0), A, B);
      for (int rc = gw; rc < MC; rc += NGW) { f32x4 h[4]; ld_f32(inp(F, IN_CTX) + (size_t)rc * 1024, F.lane, h); const float rs = row_rstd(h);
#pragma unroll
          for (int j = 0; j < 4; ++j) h[j] = h[j] * rs * A[j] + B[j];
          st_bf16(N + (size_t)(MX + rc) * 1024, F.lane, h); st_n8(F.out, (size_t)(MX + rc), F.lane, h); } }
}
template <bool MOE>
__device__ __forceinline__ void phase_T1(const Frame& F, int l) {
    const int gw = F.vcu * NWAVES + F.wave, NGW = F.G * NWAVES; bf16_t* N = wsb(F, WS_N); const bf16_t* O = wsb(F, WS_O);
    const float* gpost = inp(F, IN_GPOSTMIX) + l * 1024; const float* gpre = inp(F, IN_GPREFFN) + l * 1024;
    LAS float* WR = (LAS float*)F.lds;
    if (MOE) { const float* wr = inp(F, IN_WROUTER);
        for (int i = F.tid; i < 8192; i += NTHR) { const int d = i >> 3, e = i & 7; WR[e * 1024 + d] = wr[i]; }
        __syncthreads(); }
    for (int ch = gw; ch < 2048; ch += NGW) { const int b = ch >> 8; f32x4 P[4], A[4], B[4];
        make_gate(F, gpost, modp(F, l, b, 2), P); make_affine(F, gpre, modp(F, l, b, 4), modp(F, l, b, 3), A, B);
        int my_e = 0; float my_w = 0.f;
        bf16_t* HB = wsb(F, WS_HB); const float* X = inp(F, IN_X); u32x2 on[4]; f32x4 hn[4]; u32x2 hbn[4]; ld_raw(O + (size_t)ch * 16 * 1024, F.lane, on);
        if (MOE) ld_raw(HB + (size_t)ch * 16 * 1024, F.lane, hbn); else ld_f32(X + (size_t)ch * 16 * 1024, F.lane, hn);
        for (int rr = 0; rr < 16; ++rr) { const size_t r = (size_t)ch * 16 + rr; f32x4 o[4], h[4]; u32x2 oc[4], hbc[4];
            cp4(oc, on); if (MOE) cp4(hbc, hbn); else cp4(h, hn);
            if (rr < 15) { ld_raw(O + (r + 1) * 1024, F.lane, on); if (MOE) ld_raw(HB + (r + 1) * 1024, F.lane, hbn); else ld_f32(X + (r + 1) * 1024, F.lane, hn); }
            cvt_raw(oc, o); if (MOE) cvt_raw(hbc, h);
            const float ro = row_rstd(o);
#pragma unroll
            for (int j = 0; j < 4; ++j) h[j] = h[j] + P[j] * o[j] * ro;
            if (MOE) st_bf16(wsb(F, WS_HB1) + r * 1024, F.lane, h); else st_bf16(HB + r * 1024, F.lane, h);
            const float rh = row_rstd(h);
#pragma unroll
            for (int j = 0; j < 4; ++j) h[j] = h[j] * rh * A[j] + B[j];
            { int* n8 = (int*)((MOE ? F.ws + WS_N8M : (unsigned char*)N) + r * 1024) + F.lane;
#pragma unroll
                for (int j = 0; j < 4; ++j) n8[64 * j] = pk4_fp8(clamp8(h[j][0]), clamp8(h[j][1]), clamp8(h[j][2]), clamp8(h[j][3])); }
            if (MOE) {
                float lg[8];
#pragma unroll
                for (int e = 0; e < 8; ++e) { float s = 0.f;
#pragma unroll
                    for (int j = 0; j < 4; ++j) { const f32x4 w = *(const LAS f32x4*)(WR + e * 1024 + 4 * F.lane + 256 * j); s += (h[j][0] * w[0] + h[j][1] * w[1]) + (h[j][2] * w[2] + h[j][3] * w[3]); }
                    lg[e] = wave_sum(s); asm volatile("" ::: "memory"); }
                int i0 = 0; float l0 = lg[0];
#pragma unroll
                for (int e = 1; e < 8; ++e) if (lg[e] > l0) { l0 = lg[e]; i0 = e; }
                int i1 = -1; float l1 = -3.0e38f;
#pragma unroll
                for (int e = 0; e < 8; ++e) if (e != i0 && lg[e] > l1) { l1 = lg[e]; i1 = e; }
                const float ex = __expf(l1 - l0); const float w0 = 1.0f / (1.0f + ex), w1 = ex * w0;
                if (F.lane == 2 * rr) { my_e = i0; my_w = w0; }
                if (F.lane == 2 * rr + 1) { my_e = i1; my_w = w1; }
            }
        }
        if (MOE) {
            const bool act = F.lane < 32; unsigned rank = 0, mycnt = 0;
#pragma unroll
            for (int e = 0; e < 8; ++e) { const unsigned long long mk = __ballot(act && my_e == e); const unsigned c = (unsigned)__popcll(mk);
                if (my_e == e) rank = (unsigned)__popcll(mk & ((1ull << F.lane) - 1ull));
                if (F.lane == e) mycnt = c; }
            unsigned base = 0;
            if (F.lane < 8 && mycnt > 0) base = __hip_atomic_fetch_add(F.ctl + CW_CNT + 64 * F.lane, mycnt, __ATOMIC_RELAXED, __HIP_MEMORY_SCOPE_AGENT);
            const unsigned mybase = (unsigned)__shfl((int)base, my_e);
            if (act) { const unsigned pos = mybase + rank; const int tok = ch * 16 + (F.lane >> 1);
                ((int*)(F.ws + WS_LTOK))[my_e * 32768 + pos] = tok * 2 + (F.lane & 1); ((float*)(F.ws + WS_LW))[my_e * 32768 + pos] = my_w; }
        }
    }
    if (!MOE) {
        f32x4 P[4], A[4], B[4]; make_gate(F, gpost, modp(F, l, 8, 2), P); make_affine(F, gpre, modp(F, l, 8, 4), modp(F, l, 8, 3), A, B);
        float* HC = (float*)(F.ws + WS_HC);
        for (int rc = gw; rc < MC; rc += NGW) { f32x4 o[4], o1[4], o2[4], h[4]; const bf16_t* OP = wsb(F, WS_OP);
            ld_bf16(OP + (size_t)rc * 1024, F.lane, o); ld_bf16(OP + (size_t)(MC + rc) * 1024, F.lane, o1); ld_bf16(OP + (size_t)(2 * MC + rc) * 1024, F.lane, o2); ld_f32(inp(F, IN_CTX) + (size_t)rc * 1024, F.lane, h);
#pragma unroll
            for (int j = 0; j < 4; ++j) o[j] = o[j] + o1[j] + o2[j];
            const float ro = row_rstd(o);
#pragma unroll
            for (int j = 0; j < 4; ++j) h[j] = h[j] + P[j] * o[j] * ro;
            st_f32(HC + (size_t)rc * 1024, F.lane, h);
            const float rh = row_rstd(h);
#pragma unroll
            for (int j = 0; j < 4; ++j) h[j] = h[j] * rh * A[j] + B[j];
            { int* n8 = (int*)((unsigned char*)N + (size_t)(MX + rc) * 1024) + F.lane;
#pragma unroll
              for (int j = 0; j < 4; ++j) n8[64 * j] = pk4_fp8(clamp8(h[j][0]), clamp8(h[j][1]), clamp8(h[j][2]), clamp8(h[j][3])); } }
    }
}
template <bool MOE, bool LAST>
__device__ __forceinline__ void phase_T2(const Frame& F, int l) {
    const int gw = F.vcu * NWAVES + F.wave, NGW = F.G * NWAVES; bf16_t* N = wsb(F, WS_N); const bf16_t* Fb = wsb(F, WS_F); const bf16_t* Y2 = wsb(F, WS_Y2);
    const float* gpost = inp(F, IN_GPOSTFFN) + l * 1024;
    for (int ch = gw; ch < 2048; ch += NGW) { const int b = ch >> 8; f32x4 P[4], A[4], B[4];
        make_gate(F, gpost, modp(F, l, b, 5), P);
        if (!LAST) make_affine(F, inp(F, IN_GPREMIX) + (l + 1) * 1024, modp(F, l + 1, b, 1), modp(F, l + 1, b, 0), A, B);
        bf16_t* HB = wsb(F, WS_HB); const bf16_t* HR = MOE ? wsb(F, WS_HB1) : HB; u32x2 fn[4], gn[4], hn[4];
        { const size_t r0 = (size_t)ch * 16; if (MOE) { ld_raw(Y2 + r0 * 2048, F.lane, fn); ld_raw(Y2 + r0 * 2048 + 1024, F.lane, gn); } else ld_raw(Fb + r0 * 1024, F.lane, fn);
          ld_raw(HR + r0 * 1024, F.lane, hn); }
        for (int rr = 0; rr < 16; ++rr) { const size_t r = (size_t)ch * 16 + rr; f32x4 f[4], h[4]; u32x2 fc[4], gc[4], hc[4];
            cp4(fc, fn); if (MOE) cp4(gc, gn); cp4(hc, hn);
            if (rr < 15) { if (MOE) { ld_raw(Y2 + (r + 1) * 2048, F.lane, fn); ld_raw(Y2 + (r + 1) * 2048 + 1024, F.lane, gn); } else ld_raw(Fb + (r + 1) * 1024, F.lane, fn);
                ld_raw(HR + (r + 1) * 1024, F.lane, hn); }
            cvt_raw(fc, f); cvt_raw(hc, h);
            if (MOE) { f32x4 f2[4]; cvt_raw(gc, f2);
#pragma unroll
                for (int j = 0; j < 4; ++j) f[j] = f[j] + f2[j]; }
            const float rf = row_rstd(f);
#pragma unroll
            for (int j = 0; j < 4; ++j) h[j] = h[j] + P[j] * f[j] * rf;
            if (LAST) st_f32(F.out + r * 1024, F.lane, h); else st_bf16(HB + r * 1024, F.lane, h);
            if (!LAST) { const float rh = row_rstd(h);
#pragma unroll
                for (int j = 0; j < 4; ++j) h[j] = h[j] * rh * A[j] + B[j];
                st_bf16(N + r * 1024, F.lane, h); st_n8(F.out, r, F.lane, h); } } }
    if (!LAST) {
        f32x4 P[4], A[4], B[4]; make_gate(F, gpost, modp(F, l, 8, 5), P); make_affine(F, inp(F, IN_GPREMIX) + (l + 1) * 1024, modp(F, l + 1, 8, 1), modp(F, l + 1, 8, 0), A, B);
        float* HC = (float*)(F.ws + WS_HC);
        for (int rc = gw; rc < MC; rc += NGW) { f32x4 f[4], f1[4], h[4]; ld_bf16(Fb + (size_t)(MX + rc) * 1024, F.lane, f); ld_bf16(wsb(F, WS_FP) + (size_t)rc * 1024, F.lane, f1); ld_f32(HC + (size_t)rc * 1024, F.lane, h);
#pragma unroll
            for (int j = 0; j < 4; ++j) f[j] = f[j] + f1[j];
            const float rf = row_rstd(f);
#pragma unroll
            for (int j = 0; j < 4; ++j) h[j] = h[j] + P[j] * f[j] * rf;
            st_f32(HC + (size_t)rc * 1024, F.lane, h);
            const float rh = row_rstd(h);
#pragma unroll
            for (int j = 0; j < 4; ++j) h[j] = h[j] * rh * A[j] + B[j];
            st_bf16(N + (size_t)(MX + rc) * 1024, F.lane, h); }
    }
}

__device__ __forceinline__ void transpose_item(const float* W, int N, int k0, int n0, const float* gk, bf16_t* WT, int ldt, int drow0, LAS float* scr, int lane) {
    f32x4 v[8];
#pragma unroll
    for (int j = 0; j < 8; ++j) v[j] = *(const f32x4*)(W + (size_t)(k0 + j * 8 + (lane >> 3)) * N + n0 + 4 * (lane & 7));
#pragma unroll
    for (int j = 0; j < 8; ++j) { const int kk = j * 8 + (lane >> 3); f32x4 x = v[j]; if (gk) x = x * gk[k0 + kk];
        LAS float* d = scr + kk * 33 + 4 * (lane & 7); d[0] = x[0]; d[1] = x[1]; d[2] = x[2]; d[3] = x[3]; }
    LDS_WAIT(); asm volatile("" ::: "memory");
    const int c = lane & 7;
#pragma unroll
    for (int j = 0; j < 4; ++j) { const int n = (lane >> 3) + 8 * j; const LAS float* s = scr + (8 * c) * 33 + n;
        u32x4 o; o.x = pk2(s[0 * 33], s[1 * 33]); o.y = pk2(s[2 * 33], s[3 * 33]); o.z = pk2(s[4 * 33], s[5 * 33]); o.w = pk2(s[6 * 33], s[7 * 33]);
        *(u32x4*)(WT + (size_t)(drow0 + n) * ldt + k0 + 8 * c) = o; }
    LDS_WAIT(); asm volatile("" ::: "memory");
}
__device__ __forceinline__ void transpose_item_f8(const float* W, int N, int k0, int n0, float sc, unsigned char* WT8, int ldt, int drow0, LAS float* scr, int lane) {
    f32x4 v[8];
#pragma unroll
    for (int j = 0; j < 8; ++j) v[j] = *(const f32x4*)(W + (size_t)(k0 + j * 8 + (lane >> 3)) * N + n0 + 4 * (lane & 7));
#pragma unroll
    for (int j = 0; j < 8; ++j) { const int kk = j * 8 + (lane >> 3); const f32x4 x = v[j] * sc;
        LAS float* d = scr + kk * 33 + 4 * (lane & 7); d[0] = x[0]; d[1] = x[1]; d[2] = x[2]; d[3] = x[3]; }
    LDS_WAIT(); asm volatile("" ::: "memory");
    const int n = lane & 31;
#pragma unroll
    for (int i = 0; i < 2; ++i) { const int c = (lane >> 5) * 2 + i; const LAS float* p = scr + (16 * c) * 33 + n;
        u32x4 o; o.x = (unsigned)pk4_fp8(p[0], p[33], p[66], p[99]); o.y = (unsigned)pk4_fp8(p[132], p[165], p[198], p[231]);
        o.z = (unsigned)pk4_fp8(p[264], p[297], p[330], p[363]); o.w = (unsigned)pk4_fp8(p[396], p[429], p[462], p[495]);
        *(u32x4*)(WT8 + (size_t)(drow0 + n) * ldt + k0 + 16 * c) = o; }
    LDS_WAIT(); asm volatile("" ::: "memory");
}
__device__ __forceinline__ int map_in(int n0) {
    if (n0 < 384) return 1280 + n0;
    if (n0 < 640) return n0 - 384;
    if (n0 < 672) return 1664 + (n0 - 640);
    if (n0 < 928) return 256 + (n0 - 672);
    if (n0 < 1184) return 512 + (n0 - 928);
    if (n0 < 1440) return 1792 + (n0 - 1184);
    if (n0 < 1696) return 768 + (n0 - 1440);
    if (n0 < 1952) return 1024 + (n0 - 1696);
    return -(n0 - 1952) - 1;
}
__device__ __forceinline__ void p0_convert_small(const Frame& F, LAS float* scr) {
    const int gw = F.vcu * NWAVES + F.wave, NGW = F.G * NWAVES;
    constexpr int I_IN = 16 * 157, I_UQ = 6 * 24, I_UKV = 4 * 32, I_BR = 16 * 32, I_OUT = 16 * 32, I_L = I_IN + I_UQ + I_UKV + I_BR + I_OUT;
    constexpr int I_F1 = 16 * 88, I_F2 = 44 * 32, NIT = 2 * I_L + 2 * I_F1 + I_F2;
    for (int it = gw; it < NIT; it += NGW) {
        int r = it;
        if (r < 2 * I_L) { const int l = r / I_L; r -= l * I_L;
            if (r < I_IN) { const int kb = r / 157, nb = r % 157; const int mr = map_in(nb * 32);
                if (mr >= 0) transpose_item(inp(F, IN_WIN) + (size_t)l * 1024 * INW, INW, kb * 64, nb * 32, nullptr, layer_w(F, l, OFF_WIN), 1024, mr, scr, F.lane);
                else transpose_item_f8(inp(F, IN_WIN) + (size_t)l * 1024 * INW, INW, kb * 64, nb * 32, 32.0f, (unsigned char*)layer_w(F, l, OFF_WGL), 2048, -mr - 1, scr, F.lane);
                continue; } r -= I_IN;
            if (r < I_UQ) { const int kb = r / 24, nb = r % 24; const int n0 = nb * 32, h = n0 / 96, j = n0 % 96; const int dr = (j < 64) ? h * 64 + j : 512 + h * 32 + (j - 64);
                transpose_item(inp(F, IN_WUQ) + (size_t)l * 384 * 768, 768, kb * 64, n0, inp(F, IN_GQ) + l * 384, layer_w(F, l, OFF_WUQ), 384, dr, scr, F.lane); continue; } r -= I_UQ;
            if (r < I_UKV) { const int kb = r / 32, nb = r % 32; const int n0 = nb * 32, h = n0 / 128, j = n0 % 128; const int dr = (j < 64) ? h * 64 + j : 512 + h * 64 + (j - 64);
                transpose_item(inp(F, IN_WUKV) + (size_t)l * 256 * 1024, 1024, kb * 64, n0, inp(F, IN_GKV) + l * 256, layer_w(F, l, OFF_WUKV), 256, dr, scr, F.lane); continue; } r -= I_UKV;
            if (r < I_BR) { const int kb = r / 32, nb = r % 32; transpose_item(inp(F, IN_WBR) + (size_t)l * 1024 * 1024, 1024, kb * 64, nb * 32, nullptr, layer_w(F, l, OFF_WBR), 1024, nb * 32, scr, F.lane); continue; } r -= I_BR;
            { const int kb = r / 32, nb = r % 32; transpose_item(inp(F, IN_WOUT) + (size_t)l * 1024 * 1024, 1024, kb * 64, nb * 32, nullptr, layer_w(F, l, OFF_WOUT), 1024, nb * 32, scr, F.lane); continue; }
        }
        r -= 2 * I_L;
        if (r < 2 * I_F1) { const int which = r / I_F1; r -= which * I_F1; const int kb = r / 88, nb = r % 88, n0 = nb * 32;
            transpose_item_f8(inp(F, which ? IN_WFFN3 : IN_WFFN1), DFF, kb * 64, n0, 32.0f, (unsigned char*)wsb(F, WS_WF13), 1024, (n0 >> 7) * 256 + (n0 & 127) + which * 128, scr, F.lane); continue; }
        r -= 2 * I_F1;
        { const int kb = r / 32, nb = r % 32; transpose_item_f8(inp(F, IN_WFFN2), 1024, kb * 64, nb * 32, 64.0f, (unsigned char*)wsb(F, WS_WF2), DFF, nb * 32, scr, F.lane); }
    }
    for (int i = (F.vcu * NTHR + F.tid) * 4; i < 2 * 4 * 128 * 128; i += F.G * NTHR * 4) { const int l = i >> 16, o = i & 65535; const f32x4 v = *(const f32x4*)(inp(F, IN_WSP) + i);
        u32x2 w; w.x = pk2(v[0], v[1]); w.y = pk2(v[2], v[3]); *(u32x2*)(layer_w(F, l, OFF_WSP) + o) = w; }
}
__device__ __forceinline__ void p0_convert_moe(const Frame& F, LAS float* scr) {
    const int gw = F.vcu * NWAVES + F.wave, NGW = F.G * NWAVES;
    constexpr int I_13 = 16 * 112, I_2 = 56 * 32, I_E = 2 * I_13 + I_2;
    for (int it = gw; it < 8 * I_E; it += NGW) { const int e = it / I_E; int r = it - e * I_E;
        if (r < 2 * I_13) { const int which = r / I_13; r -= which * I_13; const int kb = r / 112, nb = r % 112, n0 = nb * 32;
            transpose_item_f8(inp(F, which ? IN_WMOE3 : IN_WMOE1) + (size_t)e * 1024 * DFE, DFE, kb * 64, n0, 32.0f, F.ws + WS_WM13 + (size_t)e * 7168 * 1024, 1024, (n0 >> 7) * 256 + (n0 & 127) + which * 128, scr, F.lane); continue; }
        r -= 2 * I_13;
        { const int kb = r / 32, nb = r % 32; transpose_item_f8(inp(F, IN_WMOE2) + (size_t)e * DFE * 1024, 1024, kb * 64, nb * 32, 64.0f, F.ws + WS_WM2 + (size_t)e * 1024 * DFE, DFE, nb * 32, scr, F.lane); }
    }
}
__device__ __forceinline__ void p0_mods(const Frame& F) {
    LAS float* sm = (LAS float*)(F.lds + 65536);
    LAS float* red = (LAS float*)(F.lds + 102400);
    float* MOD = (float*)(F.ctl + CW_MOD);
    const float* C = inp(F, IN_C); const float* CC = inp(F, IN_CCTX); const float* WM = inp(F, IN_WMOD); const float* BM = inp(F, IN_BMOD);
    __syncthreads();
    for (int i = F.tid; i < 9 * 1024; i += NTHR) { const int v = i >> 10, k = i & 1023; const float c = (v < 8) ? C[v * 1024 + k] : CC[k]; sm[i] = c / (1.0f + __expf(-c)); }
    __syncthreads();
    for (int it = F.vcu; it < 2 * 96; it += F.G) { const int l = it / 96, n = (it % 96) * 64 + F.lane; float acc[9];
#pragma unroll
        for (int v = 0; v < 9; ++v) acc[v] = 0.f;
        const float* w = WM + ((size_t)l * 1024 + F.wave * 128) * 6144 + n;
#pragma unroll 8
        for (int k = 0; k < 128; ++k) { const float wv = w[(size_t)k * 6144];
#pragma unroll
            for (int v = 0; v < 9; ++v) acc[v] += sm[v * 1024 + F.wave * 128 + k] * wv; }
#pragma unroll
        for (int v = 0; v < 9; ++v) red[(F.wave * 9 + v) * 64 + F.lane] = acc[v];
        __syncthreads();
        for (int i = F.tid; i < 9 * 64; i += NTHR) { const int v = i >> 6, c = i & 63; float s = BM[l * 6144 + (it % 96) * 64 + c];
#pragma unroll
            for (int w8 = 0; w8 < 8; ++w8) s += red[(w8 * 9 + v) * 64 + c];
            MOD[(size_t)(l * 9 + v) * 6144 + (it % 96) * 64 + c] = s; }
        __syncthreads();
    }
    if (F.vcu == 0) { float* TAB = (float*)(F.ws + WS_TAB); const int p = F.tid >> 3, j = F.tid & 7;
        const float inv = powf(10000.0f, -(float)j * 0.125f); const float ang = (float)p * inv; TAB[(p * 8 + j) * 2] = cosf(ang); TAB[(p * 8 + j) * 2 + 1] = sinf(ang); }
}

__device__ __forceinline__ f32x16 mfma32(bf16x8 a, bf16x8 b, f32x16 c) { return __builtin_amdgcn_mfma_f32_32x32x16_bf16(a, b, c, 0, 0, 0); }
__device__ __forceinline__ float max16(const f32x16& p) { float a = fmaxf(fmaxf(p[0], p[1]), fmaxf(p[2], p[3]));
#pragma unroll
    for (int r = 4; r < 16; r += 4) a = fmaxf(a, fmaxf(fmaxf(p[r], p[r + 1]), fmaxf(p[r + 2], p[r + 3])));
    return a; }
typedef float f32x2_t __attribute__((ext_vector_type(2))); typedef __bf16 bf16x2_t __attribute__((ext_vector_type(2)));
__device__ __forceinline__ unsigned cvtpk_s(float lo, float hi) { f32x2_t v = {lo, hi}; bf16x2_t b = __builtin_convertvector(v, bf16x2_t); return __builtin_bit_cast(unsigned, b); }
__device__ __forceinline__ bf16x8 pack_p(const f32x16& p, int s) { u32x4 w; w.x = cvtpk_s(p[8 * s + 0], p[8 * s + 1]); w.y = cvtpk_s(p[8 * s + 2], p[8 * s + 3]); w.z = cvtpk_s(p[8 * s + 4], p[8 * s + 5]); w.w = cvtpk_s(p[8 * s + 6], p[8 * s + 7]); return __builtin_bit_cast(bf16x8, w); }
__device__ __forceinline__ float softmax_tile(f32x16& s0, f32x16& s1, float& m_run, float& l_run) {
    float mx = fmaxf(max16(s0), max16(s1)); mx = fmaxf(mx, __shfl_xor(mx, 32));
    const float mnew = fmaxf(m_run, mx); const float alpha = fast_exp2(m_run - mnew); m_run = mnew; float ls = 0.f;
#pragma unroll
    for (int r = 0; r < 16; ++r) { s0[r] = fast_exp2(s0[r] - mnew); s1[r] = fast_exp2(s1[r] - mnew); ls += s0[r] + s1[r]; }
    l_run = l_run * alpha + ls; return alpha;
}
__device__ __forceinline__ void pv_tile(f32x16& o0, f32x16& o1, const f32x16& s0, const f32x16& s1, const LAS unsigned char* vrow) {
#pragma unroll
    for (int kb = 0; kb < 2; ++kb)
#pragma unroll
        for (int s = 0; s < 2; ++s) { const bf16x8 pb = pack_p(kb ? s1 : s0, s);
#pragma unroll
            for (int db = 0; db < 2; ++db) { const LAS unsigned char* vp = vrow + db * 32 * 136 + (kb * 32 + s * 16) * 2;
                const u32x2 lo = *(const LAS u32x2*)vp, hi2 = *(const LAS u32x2*)(vp + 16); u32x4 w; w.x = lo.x; w.y = lo.y; w.z = hi2.x; w.w = hi2.y;
                if (db == 0) o0 = mfma32(__builtin_bit_cast(bf16x8, w), pb, o0); else o1 = mfma32(__builtin_bit_cast(bf16x8, w), pb, o1); } }
}
constexpr float MLA_THR = 6.0f;
__device__ __forceinline__ float max3f_(float a, float b, float c) { return fmaxf(fmaxf(a, b), c); }
#define SBAR() __builtin_amdgcn_sched_barrier(0)
__device__ __forceinline__ void mla_unit(const Frame& F, int b, int h, const bf16_t* Qr0, bf16_t* Yr0, int NT) {
    const int tid = F.tid, lane = F.lane, r32 = lane & 31, hi = lane >> 5, wid = F.wave, half = wid >> 2;
    const bf16_t* Kh = wsb(F, WS_K) + (size_t)(b * 8 + h) * LK * 96; const bf16_t* Vh = wsb(F, WS_VT) + (size_t)(b * 8 + h) * 64 * LK;
    constexpr int KBYTES = 13312, BUFB = 13312 + 9216;
    LAS unsigned char* L = F.lds;
    bf16x8 qf[6];
#pragma unroll
    for (int t = 0; t < 6; ++t) qf[t] = *(const bf16x8*)(Qr0 + (size_t)(wid * 32 + r32) * 768 + t * 16 + hi * 8);
    const int c1 = tid + 512; const int kw0 = (tid / 12) * 208 + (tid % 12) * 16, kw1 = (c1 / 12) * 208 + (c1 % 12) * 16;
    const int vch = tid & 7; const int vw = KBYTES + (tid >> 3) * 144 + (vch >> 1) * 32 + (vch & 1) * 8;
    const bf16_t* kg = Kh + tid * 8; const bf16_t* vg = Vh + (size_t)(tid >> 3) * LK + vch * 8;
    const int kro = r32 * 208 + hi * 16, vro = KBYTES + r32 * 144 + hi * 16;
    u32x4 kr0, kr1 = (u32x4){0u, 0u, 0u, 0u}, vr;
#define MLA_GLOAD(t_) do { kr0 = *(const u32x4*)(kg + (size_t)(t_) * 6144); if (tid < 256) kr1 = *(const u32x4*)(kg + (size_t)(t_) * 6144 + 4096); vr = *(const u32x4*)(vg + (t_) * 64); } while (0)
#define MLA_LWRITE(bo_) do { *(LAS u32x4*)(L + (bo_) + kw0) = kr0; if (tid < 256) *(LAS u32x4*)(L + (bo_) + kw1) = kr1; \
        *(LAS u32x2*)(L + (bo_) + vw) = (u32x2){vr.x, vr.y}; *(LAS u32x2*)(L + (bo_) + vw + 16) = (u32x2){vr.z, vr.w}; } while (0)
#define MLA_QK(bo_) do { const LAS unsigned char* kb_ = L + (bo_) + kro; \
        { const bf16x8 a0 = *(const LAS bf16x8*)(kb_), a1 = *(const LAS bf16x8*)(kb_ + 32 * 208); s0 = mfma32(a0, qf[0], negm); s1 = mfma32(a1, qf[0], negm); } \
        _Pragma("unroll") for (int t6 = 1; t6 < 6; ++t6) { const bf16x8 a0 = *(const LAS bf16x8*)(kb_ + t6 * 32), a1 = *(const LAS bf16x8*)(kb_ + 32 * 208 + t6 * 32); s0 = mfma32(a0, qf[t6], s0); s1 = mfma32(a1, qf[t6], s1); } } while (0)
#define MLA_KLOAD(bo_) do { const LAS unsigned char* kb_ = L + (bo_) + kro; \
        _Pragma("unroll") for (int t6 = 0; t6 < 3; ++t6) { kf[2 * t6] = *(const LAS bf16x8*)(kb_ + t6 * 32); kf[2 * t6 + 1] = *(const LAS bf16x8*)(kb_ + 32 * 208 + t6 * 32); } } while (0)
#define MLA_QKR(bo_) do { const LAS unsigned char* kb_ = L + (bo_) + kro; \
        s0 = mfma32(kf[0], qf[0], negm); s1 = mfma32(kf[1], qf[0], negm); \
        _Pragma("unroll") for (int t6 = 1; t6 < 3; ++t6) { s0 = mfma32(kf[2 * t6], qf[t6], s0); s1 = mfma32(kf[2 * t6 + 1], qf[t6], s1); } \
        _Pragma("unroll") for (int t6 = 3; t6 < 6; ++t6) { const bf16x8 a0 = *(const LAS bf16x8*)(kb_ + t6 * 32), a1 = *(const LAS bf16x8*)(kb_ + 32 * 208 + t6 * 32); s0 = mfma32(a0, qf[t6], s0); s1 = mfma32(a1, qf[t6], s1); } } while (0)
#define MLA_PV(bo_) do { const LAS unsigned char* vrow_ = L + (bo_) + vro; \
        _Pragma("unroll") for (int g = 0; g < 4; ++g) { const bf16x8 v0 = *(const LAS bf16x8*)(vrow_ + g * 32), v1 = *(const LAS bf16x8*)(vrow_ + 32 * 144 + g * 32); o0 = mfma32(v0, pw[g], o0); o1 = mfma32(v1, pw[g], o1); } } while (0)
#define MLA_ROWMAX(mx_, a_, b_) do { mx_ = max3f_(a_[0], a_[1], b_[0]); _Pragma("unroll") for (int r = 2; r < 16; r += 2) mx_ = max3f_(mx_, a_[r], a_[r + 1]); \
        _Pragma("unroll") for (int r = 1; r < 15; r += 2) mx_ = max3f_(mx_, b_[r], b_[r + 1]); mx_ = fmaxf(mx_, b_[15]); \
        { auto rr = __builtin_amdgcn_permlane32_swap(__builtin_bit_cast(unsigned, mx_), __builtin_bit_cast(unsigned, mx_), false, false); \
          mx_ = fmaxf(__builtin_bit_cast(float, rr[0]), __builtin_bit_cast(float, rr[1])); } } while (0)
    MLA_GLOAD(0);
    __syncthreads();
    MLA_LWRITE(0);
    MLA_GLOAD(1);
    MLA_LWRITE(BUFB);
    __syncthreads();
    if (half == 1) __syncthreads();
    float m_ref = 0.f, l_run = 0.f, pend_f = 1.0f; bool pend = false; f32x16 o0 = {}, o1 = {}, negm = {};
    bf16x8 pw[4], kf[6];
    {
        f32x16 s0, s1;
        if (2 < NT) MLA_GLOAD(2);
        MLA_QK(0);
        __syncthreads();
        float mx; MLA_ROWMAX(mx, s0, s1); m_ref = mx; float ls = 0.f;
#pragma unroll
        for (int r = 0; r < 16; ++r) { negm[r] = -mx; s0[r] = fast_exp2(s0[r] - mx); s1[r] = fast_exp2(s1[r] - mx); ls += s0[r] + s1[r]; }
        l_run = ls; pw[0] = pack_p(s0, 0); pw[1] = pack_p(s0, 1); pw[2] = pack_p(s1, 0); pw[3] = pack_p(s1, 1);
        MLA_KLOAD(BUFB);
        if (2 < NT) MLA_LWRITE(2 * BUFB);
        __syncthreads();
    }
    int pb = 0, cb = BUFB, sb = 3 * BUFB;
    for (int t = 1; t < NT; ++t) {
        f32x16 s0, s1;
        if (t + 2 < NT) MLA_GLOAD(t + 2);
        {
            const LAS unsigned char* kb_ = L + cb + kro; const LAS unsigned char* vrow_ = L + pb + vro; bf16x8 kq[6], vf[8];
#pragma unroll
            for (int t6 = 3; t6 < 6; ++t6) { kq[2 * (t6 - 3)] = *(const LAS bf16x8*)(kb_ + t6 * 32); kq[2 * (t6 - 3) + 1] = *(const LAS bf16x8*)(kb_ + 32 * 208 + t6 * 32); }
#pragma unroll
            for (int g = 0; g < 2; ++g) { vf[2 * g] = *(const LAS bf16x8*)(vrow_ + g * 32); vf[2 * g + 1] = *(const LAS bf16x8*)(vrow_ + 32 * 144 + g * 32); }
            SBAR();
            s0 = mfma32(kf[0], qf[0], negm); s1 = mfma32(kf[1], qf[0], negm);
#pragma unroll
            for (int t6 = 1; t6 < 3; ++t6) { s0 = mfma32(kf[2 * t6], qf[t6], s0); s1 = mfma32(kf[2 * t6 + 1], qf[t6], s1); }
            SBAR();
#pragma unroll
            for (int g = 2; g < 4; ++g) { vf[2 * g] = *(const LAS bf16x8*)(vrow_ + g * 32); vf[2 * g + 1] = *(const LAS bf16x8*)(vrow_ + 32 * 144 + g * 32); }
            SBAR();
#pragma unroll
            for (int t6 = 3; t6 < 6; ++t6) { s0 = mfma32(kq[2 * (t6 - 3)], qf[t6], s0); s1 = mfma32(kq[2 * (t6 - 3) + 1], qf[t6], s1); }
#pragma unroll
            for (int g = 0; g < 4; ++g) { o0 = mfma32(vf[2 * g], pw[g], o0); o1 = mfma32(vf[2 * g + 1], pw[g], o1); }
        }
        asm volatile("" : "+v"(o0), "+v"(o1));
        SBAR();
        __syncthreads();
        float ls = 0.f;
#pragma unroll
        for (int r = 0; r < 16; ++r) { s0[r] = fast_exp2(s0[r]); s1[r] = fast_exp2(s1[r]); ls += s0[r] + s1[r]; }
        pw[0] = pack_p(s0, 0); pw[1] = pack_p(s0, 1); pw[2] = pack_p(s1, 0); pw[3] = pack_p(s1, 1);
        if (pend) {
            asm volatile("" ::: "memory");
#pragma unroll
            for (int r = 0; r < 16; ++r) { o0[r] *= pend_f; o1[r] *= pend_f; }
            l_run *= pend_f; }
        l_run += ls;
        float lv = ls; { auto rr = __builtin_amdgcn_permlane32_swap(__builtin_bit_cast(unsigned, lv), __builtin_bit_cast(unsigned, lv), false, false);
            lv = fmaxf(__builtin_bit_cast(float, rr[0]), __builtin_bit_cast(float, rr[1])); }
        pend = __any(lv > 4096.0f);
        if (pend) { asm volatile("" ::: "memory");
            const float dl = (lv > 2.0f) ? (float)((int)(__builtin_bit_cast(unsigned, lv) >> 23) - 127) : 0.f; m_ref += dl; pend_f = fast_exp2(-dl);
#pragma unroll
            for (int r = 0; r < 16; ++r) negm[r] = -m_ref; }
        if (t + 1 < NT) MLA_KLOAD((cb == 3 * BUFB) ? 0 : cb + BUFB);
        if (t + 2 < NT) MLA_LWRITE(sb);
        __syncthreads();
        pb = cb; cb = (cb == 3 * BUFB) ? 0 : cb + BUFB; sb = (sb == 3 * BUFB) ? 0 : sb + BUFB;
    }
    MLA_PV(pb);
    if (half == 0) __syncthreads();
#undef MLA_GLOAD
#undef MLA_LWRITE
#undef MLA_QK
#undef MLA_KLOAD
#undef MLA_QKR
#undef MLA_PV
#undef MLA_ROWMAX
    const float inv = 1.0f / (l_run + __shfl_xor(l_run, 32));
    bf16_t* yp = Yr0 + (size_t)(wid * 32 + r32) * 1024 + hi * 4;
#pragma unroll
    for (int g = 0; g < 4; ++g) { u32x2 w; w.x = pk2(o0[4 * g] * inv, o0[4 * g + 1] * inv); w.y = pk2(o0[4 * g + 2] * inv, o0[4 * g + 3] * inv); *(u32x2*)(yp + 8 * g) = w;
        w.x = pk2(o1[4 * g] * inv, o1[4 * g + 1] * inv); w.y = pk2(o1[4 * g + 2] * inv, o1[4 * g + 3] * inv); *(u32x2*)(yp + 32 + 8 * g) = w; }
}
__device__ __forceinline__ void mla_unit2(const Frame& F, int b, int h, const bf16_t* Qr0, bf16_t* Yr0, int NT) {
    int lane = F.lane; asm volatile("" : "+v"(lane));
    const int wid = F.wave, tid = wid * 64 + lane, r32 = lane & 31, hi = lane >> 5, half = wid >> 2;
    const bf16_t* Kh = wsb(F, WS_K) + (size_t)(b * 8 + h) * LK * 96; const bf16_t* Vh = wsb(F, WS_VT) + (size_t)(b * 8 + h) * 64 * LK;
    constexpr int KBYTES = 13312, BUFB = 13312 + 9216;
    LAS unsigned char* L = F.lds;
    bf16x8 qf[2][6];
#pragma unroll
    for (int q = 0; q < 2; ++q)
#pragma unroll
        for (int t = 0; t < 6; ++t) qf[q][t] = *(const bf16x8*)(Qr0 + (size_t)(wid * 64 + q * 32 + r32) * 768 + t * 16 + hi * 8);
    const int c1 = tid + 512; const int kw0 = (tid / 12) * 208 + (tid % 12) * 16, kw1 = (c1 / 12) * 208 + (c1 % 12) * 16;
    const int vch = tid & 7; const int vw = KBYTES + (tid >> 3) * 144 + (vch >> 1) * 32 + (vch & 1) * 8;
    const bf16_t* kg = Kh + tid * 8; const bf16_t* vg = Vh + (size_t)(tid >> 3) * LK + vch * 8;
    const int kro = r32 * 208 + hi * 16, vro = KBYTES + r32 * 144 + hi * 16;
    u32x4 kr0, kr1, vr;
#define M2_GLOAD(t_) do { kr0 = *(const u32x4*)(kg + (size_t)(t_) * 6144); vr = *(const u32x4*)(vg + (t_) * 64); } while (0)
#define M2_GLOAD1(t_) do { kr1 = *(const u32x4*)(kg + (size_t)(t_) * 6144 + 4096); } while (0)
#define M2_LWRITE(bo_) do { *(LAS u32x4*)(L + (bo_) + kw0) = kr0; if (tid < 256) *(LAS u32x4*)(L + (bo_) + kw1) = kr1; \
        *(LAS u32x2*)(L + (bo_) + vw) = (u32x2){vr.x, vr.y}; *(LAS u32x2*)(L + (bo_) + vw + 16) = (u32x2){vr.z, vr.w}; } while (0)
#define M2_QK(bo_) do { const LAS unsigned char* kb_ = L + (bo_) + kro; \
        _Pragma("unroll") for (int t6 = 0; t6 < 6; ++t6) { const bf16x8 a0 = *(const LAS bf16x8*)(kb_ + t6 * 32), a1 = *(const LAS bf16x8*)(kb_ + 32 * 208 + t6 * 32); \
            s[0][0] = mfma32(a0, qf[0][t6], s[0][0]); s[1][0] = mfma32(a0, qf[1][t6], s[1][0]); s[0][1] = mfma32(a1, qf[0][t6], s[0][1]); s[1][1] = mfma32(a1, qf[1][t6], s[1][1]); } } while (0)
#define M2_PV(bo_) do { const LAS unsigned char* vrow_ = L + (bo_) + vro; \
        _Pragma("unroll") for (int g = 0; g < 4; ++g) { const bf16x8 v0 = *(const LAS bf16x8*)(vrow_ + g * 32), v1 = *(const LAS bf16x8*)(vrow_ + 32 * 144 + g * 32); \
            o[0][0] = mfma32(v0, pw[0][g], o[0][0]); o[1][0] = mfma32(v0, pw[1][g], o[1][0]); o[0][1] = mfma32(v1, pw[0][g], o[0][1]); o[1][1] = mfma32(v1, pw[1][g], o[1][1]); } } while (0)
    auto swapmax = [&](float v) { auto rr = __builtin_amdgcn_permlane32_swap(__builtin_bit_cast(unsigned, v), __builtin_bit_cast(unsigned, v), false, false);
        return fmaxf(__builtin_bit_cast(float, rr[0]), __builtin_bit_cast(float, rr[1])); };
    M2_GLOAD(0); M2_GLOAD1(0);
    __syncthreads();
    M2_LWRITE(0);
    M2_GLOAD(1); M2_GLOAD1(1);
    M2_LWRITE(BUFB);
    __syncthreads();
    if (half == 1) __syncthreads();
    float m[2] = {0.f, 0.f}, l[2] = {0.f, 0.f}, pf[2] = {1.f, 1.f}; bool pend[2] = {false, false};
    f32x16 o[2][2] = {}; bf16x8 pw[2][4], fr[3];
#define M2_FPRE(bo_) do { const LAS unsigned char* kp_ = L + (bo_) + kro; fr[0] = *(const LAS bf16x8*)(kp_); fr[1] = *(const LAS bf16x8*)(kp_ + 32 * 208); fr[2] = *(const LAS bf16x8*)(kp_ + 32); } while (0)
    {
        f32x16 s[2][2] = {};
        M2_QK(0);
        __syncthreads();
        if (2 < NT) { M2_GLOAD(2); M2_GLOAD1(2); }
        SBAR();
#pragma unroll
        for (int q = 0; q < 2; ++q) { const float mx = swapmax(fmaxf(max16(s[q][0]), max16(s[q][1]))); m[q] = mx; float ls = 0.f;
#pragma unroll
            for (int r = 0; r < 16; ++r) { s[q][0][r] = fast_exp2(s[q][0][r] - mx); s[q][1][r] = fast_exp2(s[q][1][r] - mx); ls += s[q][0][r] + s[q][1][r]; }
            l[q] = ls; pw[q][0] = pack_p(s[q][0], 0); pw[q][1] = pack_p(s[q][0], 1); pw[q][2] = pack_p(s[q][1], 0); pw[q][3] = pack_p(s[q][1], 1); }
        if (2 < NT) M2_LWRITE(2 * BUFB);
        M2_FPRE(BUFB);
        __syncthreads();
    }
    int pb = 0, cb = BUFB, sb = 3 * BUFB;
    for (int t = 1; t < NT; ++t) {
        f32x16 s[2][2] = {};
        {
            const LAS unsigned char* kb_ = L + cb + kro; const LAS unsigned char* vrow_ = L + pb + vro;
#define M2_FADDR(i_) (((i_) < 12) ? kb_ + ((i_) >> 1) * 32 + ((i_) & 1) * 32 * 208 : vrow_ + (((i_) - 12) >> 1) * 32 + ((i_) & 1) * 32 * 144)
#pragma unroll
            for (int i = 0; i < 20; ++i) { const bf16x8 f = fr[i % 3];
                SBAR();
                if (i < 12) { s[0][i & 1] = mfma32(f, qf[0][i >> 1], s[0][i & 1]); s[1][i & 1] = mfma32(f, qf[1][i >> 1], s[1][i & 1]); }
                else { o[0][i & 1] = mfma32(f, pw[0][(i - 12) >> 1], o[0][i & 1]); o[1][i & 1] = mfma32(f, pw[1][(i - 12) >> 1], o[1][i & 1]); }
                SBAR();
                if (i + 3 < 20) fr[i % 3] = *(const LAS bf16x8*)M2_FADDR(i + 3); }
#undef M2_FADDR
        }
        asm volatile("" : "+v"(o[0][0]), "+v"(o[0][1]), "+v"(o[1][0]), "+v"(o[1][1]));
        SBAR();
        __syncthreads();
        if (t + 2 < NT) M2_GLOAD(t + 2);
        SBAR();
#pragma unroll
        for (int q = 0; q < 2; ++q) { const float mq = m[q]; float ls = 0.f;
#pragma unroll
            for (int r = 0; r < 16; ++r) { s[q][0][r] = fast_exp2(s[q][0][r] - mq); s[q][1][r] = fast_exp2(s[q][1][r] - mq); ls += s[q][0][r] + s[q][1][r]; }
            pw[q][0] = pack_p(s[q][0], 0); pw[q][1] = pack_p(s[q][0], 1); pw[q][2] = pack_p(s[q][1], 0); pw[q][3] = pack_p(s[q][1], 1);
            if (q == 0) { SBAR(); if (t + 2 < NT) M2_GLOAD1(t + 2); SBAR(); }
            if (pend[q]) { asm volatile("" ::: "memory");
#pragma unroll
                for (int r = 0; r < 16; ++r) { o[q][0][r] *= pf[q]; o[q][1][r] *= pf[q]; }
                l[q] *= pf[q]; }
            l[q] += ls;
            const float lv = swapmax(ls);
            pend[q] = __any(lv > 4096.0f);
            if (pend[q]) { asm volatile("" ::: "memory"); const float dl = (lv > 2.0f) ? (float)((int)(__builtin_bit_cast(unsigned, lv) >> 23) - 127) : 0.f; m[q] += dl; pf[q] = fast_exp2(-dl); } }
        if (t + 2 < NT) M2_LWRITE(sb);
        if (t + 1 < NT) M2_FPRE((cb == 3 * BUFB) ? 0 : cb + BUFB);
        __syncthreads();
        pb = cb; cb = (cb == 3 * BUFB) ? 0 : cb + BUFB; sb = (sb == 3 * BUFB) ? 0 : sb + BUFB;
    }
    M2_PV(pb);
    if (half == 0) __syncthreads();
#undef M2_GLOAD
#undef M2_FPRE
#undef M2_GLOAD1
#undef M2_LWRITE
#undef M2_QK
#undef M2_PV
    int le = F.lane; asm volatile("" : "+v"(le));
#pragma unroll
    for (int q = 0; q < 2; ++q) { const float inv = 1.0f / (l[q] + __builtin_bit_cast(float, __builtin_amdgcn_ds_bpermute((le ^ 32) << 2, __builtin_bit_cast(int, l[q]))));
        bf16_t* yp = Yr0 + (size_t)(wid * 64 + q * 32 + (le & 31)) * 1024 + (le >> 5) * 4;
#pragma unroll
        for (int g = 0; g < 4; ++g) { u32x2 w; w.x = pk2(o[q][0][4 * g] * inv, o[q][0][4 * g + 1] * inv); w.y = pk2(o[q][0][4 * g + 2] * inv, o[q][0][4 * g + 3] * inv); *(u32x2*)(yp + 8 * g) = w;
            w.x = pk2(o[q][1][4 * g] * inv, o[q][1][4 * g + 1] * inv); w.y = pk2(o[q][1][4 * g + 2] * inv, o[q][1][4 * g + 3] * inv); *(u32x2*)(yp + 32 + 8 * g) = w; } }
}
__device__ __forceinline__ void phase_mla(const Frame& F, bool with_ctx) {
    const bf16_t* Q = wsb(F, WS_Q); bf16_t* Y = wsb(F, WS_Y);
    for (int u = F.vcu; u < 512; u += F.G) { const int bh = u >> 3, qb = u & 7, b = bh >> 3, h = bh & 7; const size_t row0 = (size_t)b * 4096 + qb * 512;
        mla_unit2(F, b, h, Q + row0 * 768 + h * 96, Y + row0 * 1024 + h * 64, LK / 64); }
    if (with_ctx) for (int u = F.vcu; u < 64; u += F.G) { const int b = u >> 3, h = u & 7; const size_t row0 = (size_t)MX + b * 256;
        mla_unit(F, b, h, Q + row0 * 768 + h * 96, Y + row0 * 1024 + h * 64, CTX / 64); }
}

constexpr int NA_BUF = 68608, NA_RP = 137216 + 128;
template <int QH>
__device__ __forceinline__ void na_unit(const Frame& F, int b, int qrow0, bool latent, int grow) {
    int lane = F.lane; asm volatile("" : "+v"(lane));
    const int wid = F.wave, tid = wid * 64 + lane, r32 = lane & 31, hi = lane >> 5, h = wid >> 1, qc = QH * 32 + r32;
    const bf16_t* NAQ = wsb(F, WS_NAQ); const bf16_t* NAK = wsb(F, WS_NAK); const bf16_t* NAVT = wsb(F, WS_NAVT) + (size_t)b * 256 * LK; bf16_t* Y = wsb(F, WS_Y);
    LAS unsigned char* L = F.lds;
    const LAS float* RP = (const LAS float*)(L + NA_RP);
    bf16x8 qf[4];
#pragma unroll
    for (int t = 0; t < 4; ++t) qf[t] = *(const bf16x8*)(NAQ + (size_t)(qrow0 + qc) * 256 + h * 64 + t * 16 + hi * 8);
    const int rs = latent ? (grow < 4 ? 0 : (grow > 60 ? 56 : grow - 4)) : 0;
    const int ws_ = qc < 8 ? 0 : (qc > 56 ? 48 : qc - 8);
    float m_ref = 0.f, l_run = 0.f; f32x16 o0 = {}, o1 = {}, negm, cwm;
    unsigned mbits = 0u; float pm[4];
#pragma unroll
    for (int r = 0; r < 16; ++r) { const int kcm = (r & 3) + 8 * (r >> 2) + 4 * hi + 32 * QH; mbits |= ((unsigned)(kcm - ws_) < 16u) ? (1u << r) : 0u; }
#pragma unroll
    for (int r = 0; r < 4; ++r) { const int kcp = r + 4 * hi + (QH == 0 ? 32 : 24); pm[r] = ((unsigned)(kcp - ws_) < 16u) ? 0.f : -1.0e30f; }
    u32x4 kr[4], vr[4];
    const int t0 = latent ? 0 : 8;
    auto issue = [&](int t) {
        const unsigned char* kg = (const unsigned char*)((t < 8) ? NAK + ((size_t)b * 4096 + (rs + t) * 64) * 256 : NAK + ((size_t)MX + b * 256 + (t - 8) * 64) * 256);
        const unsigned char* vg = (const unsigned char*)(NAVT + ((t < 8) ? CTX + (rs + t) * 64 : (t - 8) * 64));
#pragma unroll
        for (int i = 0; i < 4; ++i) { kr[i] = *(const u32x4*)(kg + (unsigned)(tid * 16 + i * 8192)); vr[i] = *(const u32x4*)(vg + (unsigned)(((tid >> 3) + 64 * i) * (LK * 2) + (tid & 7) * 16)); }
    };
    auto lwrite = [&](int bo) {
#pragma unroll
        for (int i = 0; i < 4; ++i) { const int c = tid + 512 * i; *(LAS u32x4*)(L + bo + (c >> 5) * 528 + (c & 31) * 16) = kr[i];
            LAS unsigned char* vp = L + bo + 33792 + (c >> 3) * 136 + (c & 7) * 16; *(LAS u32x2*)vp = (u32x2){vr[i].x, vr[i].y}; *(LAS u32x2*)(vp + 8) = (u32x2){vr[i].z, vr[i].w}; }
    };
    auto set_c = [&]() {
        unsigned mb = mbits; asm volatile("" : "+v"(mb));
#pragma unroll
        for (int r = 0; r < 16; ++r) { negm[r] = -m_ref; cwm[r] = ((mb >> r) & 1u) ? -m_ref : -1.0e30f; }
    };
    auto swapmax = [&](float v) { auto rr = __builtin_amdgcn_permlane32_swap(__builtin_bit_cast(unsigned, v), __builtin_bit_cast(unsigned, v), false, false);
        return fmaxf(__builtin_bit_cast(float, rr[0]), __builtin_bit_cast(float, rr[1])); };
    auto guard = [&](float ls) {
        const float lv = swapmax(ls);
        if (__any(lv > 4096.0f)) { asm volatile("" ::: "memory");
            const float dl = (lv > 2.0f) ? (float)((int)(__builtin_bit_cast(unsigned, lv) >> 23) - 127) : 0.f; m_ref += dl; const float f = fast_exp2(-dl);
#pragma unroll
            for (int r = 0; r < 16; ++r) { o0[r] *= f; o1[r] *= f; }
            l_run *= f; set_c(); }
    };
#define NA_VMMA(kb_, s_, pb_) do { _Pragma("unroll") for (int db = 0; db < 2; ++db) { const LAS unsigned char* vp = vrow + db * 32 * 136 + ((kb_) * 32 + (s_) * 16) * 2; \
            const u32x2 lo = *(const LAS u32x2*)vp, hi2 = *(const LAS u32x2*)(vp + 16); u32x4 w; w.x = lo.x; w.y = lo.y; w.z = hi2.x; w.w = hi2.y; \
            if (db == 0) o0 = mfma32(__builtin_bit_cast(bf16x8, w), pb_, o0); else o1 = mfma32(__builtin_bit_cast(bf16x8, w), pb_, o1); } } while (0)
    set_c();
    issue(t0);
    __syncthreads();
    lwrite((t0 & 1) * NA_BUF);
    issue(t0 + 1);
    __syncthreads();
    if (latent) for (int t = 0; t < 8; ++t) {
        const int bo = (t & 1) * NA_BUF;
        lwrite(NA_BUF - bo); issue(t + 2);
        const LAS unsigned char* kb = L + bo + r32 * 528 + h * 128 + hi * 16;
        f32x16 s0, s1;
        { const bf16x8 a0 = *(const LAS bf16x8*)(kb), a1 = *(const LAS bf16x8*)(kb + 32 * 528); s0 = mfma32(a0, qf[0], QH == 0 ? cwm : negm); s1 = mfma32(a1, qf[0], QH == 0 ? negm : cwm); }
#pragma unroll
        for (int t4 = 1; t4 < 4; ++t4) { const bf16x8 a0 = *(const LAS bf16x8*)(kb + t4 * 32), a1 = *(const LAS bf16x8*)(kb + 32 * 528 + t4 * 32); s0 = mfma32(a0, qf[t4], s0); s1 = mfma32(a1, qf[t4], s1); }
        const LAS float* rp = RP + (h * 15 + (rs + t - grow + 7)) * 31 + (15 - qc);
#pragma unroll
        for (int r = 0; r < 16; ++r) { const int kc0 = (r & 3) + 8 * (r >> 2) + 4 * hi, kc1 = kc0 + 32;
            if (QH == 0) { s0[r] += rp[kc0]; if (r < 4) s1[r] += rp[kc1] + pm[r]; }
            else { s1[r] += rp[kc1]; if (r >= 12) s0[r] += rp[kc0] + pm[r - 12]; } }
        if (t == 0) { float mx = -1.0e30f;
#pragma unroll
            for (int r = 0; r < 16; ++r) { if (QH == 0 || r >= 12) mx = fmaxf(mx, s0[r]); if (QH == 1 || r < 4) mx = fmaxf(mx, s1[r]); }
            mx = swapmax(mx); m_ref = mx;
#pragma unroll
            for (int r = 0; r < 16; ++r) { s0[r] -= mx; s1[r] -= mx; } }
        float ls = 0.f;
#pragma unroll
        for (int r = 0; r < 16; ++r) { if (QH == 0 || r >= 12) { s0[r] = fast_exp2(s0[r]); ls += s0[r]; } else s0[r] = 0.f;
            if (QH == 1 || r < 4) { s1[r] = fast_exp2(s1[r]); ls += s1[r]; } else s1[r] = 0.f; }
        l_run += ls;
        const LAS unsigned char* vrow = L + bo + 33792 + (h * 64 + r32) * 136 + hi * 8;
        if (QH == 0) { NA_VMMA(0, 0, pack_p(s0, 0)); NA_VMMA(0, 1, pack_p(s0, 1)); NA_VMMA(1, 0, pack_p(s1, 0)); }
        else { NA_VMMA(0, 1, pack_p(s0, 1)); NA_VMMA(1, 0, pack_p(s1, 0)); NA_VMMA(1, 1, pack_p(s1, 1)); }
        if (t == 0) set_c(); else guard(ls);
        __syncthreads();
    }
    for (int t = 8; t < 12; ++t) {
        const int bo = (t & 1) * NA_BUF;
        if (t + 1 < 12) lwrite(NA_BUF - bo);
        if (t + 2 < 12) issue(t + 2);
        const LAS unsigned char* kb = L + bo + r32 * 528 + h * 128 + hi * 16;
        f32x16 s0, s1;
        { const bf16x8 a0 = *(const LAS bf16x8*)(kb), a1 = *(const LAS bf16x8*)(kb + 32 * 528); s0 = mfma32(a0, qf[0], negm); s1 = mfma32(a1, qf[0], negm); }
#pragma unroll
        for (int t4 = 1; t4 < 4; ++t4) { const bf16x8 a0 = *(const LAS bf16x8*)(kb + t4 * 32), a1 = *(const LAS bf16x8*)(kb + 32 * 528 + t4 * 32); s0 = mfma32(a0, qf[t4], s0); s1 = mfma32(a1, qf[t4], s1); }
        const bool first = !latent && t == 8;
        if (first) { float mx = swapmax(fmaxf(max16(s0), max16(s1))); m_ref = mx;
#pragma unroll
            for (int r = 0; r < 16; ++r) { s0[r] -= mx; s1[r] -= mx; } }
        float ls = 0.f;
#pragma unroll
        for (int r = 0; r < 16; ++r) { s0[r] = fast_exp2(s0[r]); s1[r] = fast_exp2(s1[r]); ls += s0[r] + s1[r]; }
        l_run += ls;
        const LAS unsigned char* vrow = L + bo + 33792 + (h * 64 + r32) * 136 + hi * 8;
        NA_VMMA(0, 0, pack_p(s0, 0)); NA_VMMA(0, 1, pack_p(s0, 1)); NA_VMMA(1, 0, pack_p(s1, 0)); NA_VMMA(1, 1, pack_p(s1, 1));
        if (first) set_c(); else guard(ls);
        __syncthreads();
    }
#undef NA_VMMA
    int le = F.lane; asm volatile("" : "+v"(le));
    const float inv = 1.0f / (l_run + __builtin_bit_cast(float, __builtin_amdgcn_ds_bpermute((le ^ 32) << 2, __builtin_bit_cast(int, l_run))));
    bf16_t* yp = Y + (size_t)(qrow0 + QH * 32 + (le & 31)) * 1024 + 512 + h * 64 + (le >> 5) * 4;
#pragma unroll
    for (int g = 0; g < 4; ++g) { u32x2 w; w.x = pk2(o0[4 * g] * inv, o0[4 * g + 1] * inv); w.y = pk2(o0[4 * g + 2] * inv, o0[4 * g + 3] * inv); *(u32x2*)(yp + 8 * g) = w;
        w.x = pk2(o1[4 * g] * inv, o1[4 * g + 1] * inv); w.y = pk2(o1[4 * g + 2] * inv, o1[4 * g + 3] * inv); *(u32x2*)(yp + 32 + 8 * g) = w; }
}
__device__ __forceinline__ void phase_na(const Frame& F, int l, bool with_ctx) {
    LAS float* RP = (LAS float*)(F.lds + NA_RP);
    __syncthreads();
    for (int i = F.tid; i < 4 * 15 * 31; i += NTHR) RP[i] = inp(F, IN_RPB)[l * 1860 + i] * LOG2E;
    if (F.tid < 32) { RP[F.tid - 32] = 0.f; RP[1860 + F.tid] = 0.f; }
    __syncthreads();
    const int nx = (F.vcu < 512) ? (512 - F.vcu + F.G - 1) / F.G : 0, cu0 = F.G - 1 - F.vcu;
    const int nc = (with_ctx && cu0 < 32) ? (32 - cu0 + F.G - 1) / F.G : 0;
    for (int k = 0; k < nx + nc; ++k) { const bool lat = k < nx; const int u = lat ? F.vcu + k * F.G : cu0 + (k - nx) * F.G;
        const int b = lat ? (u >> 6) : (u >> 2), q0 = lat ? b * 4096 + (u & 63) * 64 : MX + b * 256 + (u & 3) * 64, gr = lat ? (u & 63) : 0;
        if ((F.wave & 1) == 0) na_unit<0>(F, b, q0, lat, gr); else na_unit<1>(F, b, q0, lat, gr); }
    __syncthreads();
}

__device__ __forceinline__ void cm_unit(const Frame& F, int l, int row0) {
    int lane = F.lane; asm volatile("" : "+v"(lane));
    const int r32 = lane & 31, hi = lane >> 5, wid = F.wave;
    const bf16_t* U = wsb(F, WS_U); const bf16_t* V = wsb(F, WS_V); bf16_t* Y = wsb(F, WS_Y); const bf16_t* WSP = layer_w(F, l, OFF_WSP);
    LAS unsigned char* L = F.lds;
    __syncthreads();
    { const f32x4 gv = *(const f32x4*)(inp(F, IN_GV) + l * 256 + 4 * lane), bv = *(const f32x4*)(inp(F, IN_BV) + l * 256 + 4 * lane);
      u32x2 w[16];
#pragma unroll
      for (int i = 0; i < 16; ++i) w[i] = *(const u32x2*)(V + (size_t)(row0 + wid * 16 + i) * 256 + 4 * lane);
#pragma unroll
      for (int i = 0; i < 16; ++i) { const int q = wid * 16 + i;
          f32x4 x = (f32x4){bf_lo(w[i].x), bf_hi(w[i].x), bf_lo(w[i].y), bf_hi(w[i].y)};
          const float mu = wave_sum((x[0] + x[1]) + (x[2] + x[3])) * (1.0f / 256.0f); x = x - mu;
          const float rs = __builtin_amdgcn_rsqf(wave_sum((x[0] * x[0] + x[1] * x[1]) + (x[2] * x[2] + x[3] * x[3])) * (1.0f / 256.0f) + EPS);
          x = x * rs * gv + bv;
#pragma unroll
          for (int j = 0; j < 4; ++j) *(LAS unsigned short*)(L + (4 * lane + j) * 272 + q * 2) = (unsigned short)f2bf(x[j]); } }
    __syncthreads();
    const int g = wid >> 1, ph = wid & 1;
    const float* bsp = inp(F, IN_BSP) + (l * 4 + g) * 128 + ph * 64 + 4 * hi;
    f32x16 acc[2][2];
#pragma unroll
    for (int pb = 0; pb < 2; ++pb)
#pragma unroll
        for (int r = 0; r < 16; ++r) { const float bs = bsp[pb * 32 + (r & 3) + 8 * (r >> 2)]; acc[pb][0][r] = bs; acc[pb][1][r] = bs; }
#pragma unroll
    for (int ks = 0; ks < 8; ++ks) { bf16x8 a[2], bq[2];
#pragma unroll
        for (int pb = 0; pb < 2; ++pb) a[pb] = *(const bf16x8*)(WSP + (size_t)(g * 128 + ph * 64 + pb * 32 + r32) * 128 + ks * 16 + hi * 8);
#pragma unroll
        for (int cb = 0; cb < 2; ++cb) bq[cb] = *(const LAS bf16x8*)(L + (g * 64 + cb * 32 + r32) * 272 + (ks * 16 + hi * 8) * 2);
#pragma unroll
        for (int pb = 0; pb < 2; ++pb)
#pragma unroll
            for (int cb = 0; cb < 2; ++cb) acc[pb][cb] = mfma32(a[pb], bq[cb], acc[pb][cb]); }
    const int tid = wid * 64 + lane, tk = tid >> 5, c8 = tid & 31;
    u32x4 uv[8];
#pragma unroll
    for (int i = 0; i < 8; ++i) uv[i] = *(const u32x4*)(U + (size_t)(row0 + tk + 16 * i) * 256 + c8 * 8);
    __syncthreads();
#pragma unroll
    for (int pb = 0; pb < 2; ++pb)
#pragma unroll
        for (int r = 0; r < 16; ++r)
#pragma unroll
            for (int cb = 0; cb < 2; ++cb) *(LAS float*)(L + (ph * 64 + pb * 32 + (r & 3) + 8 * (r >> 2) + 4 * hi) * 1040 + (g * 64 + cb * 32 + r32) * 4) = acc[pb][cb][r];
    __syncthreads();
#pragma unroll
    for (int i = 0; i < 8; ++i) { const LAS f32x4* tp = (const LAS f32x4*)(L + (tk + 16 * i) * 1040 + c8 * 32); const f32x4 t0 = tp[0], t1 = tp[1]; const u32x4 u4 = uv[i];
        u32x4 y; y.x = pk2(bf_lo(u4.x) * t0[0], bf_hi(u4.x) * t0[1]); y.y = pk2(bf_lo(u4.y) * t0[2], bf_hi(u4.y) * t0[3]);
        y.z = pk2(bf_lo(u4.z) * t1[0], bf_hi(u4.z) * t1[1]); y.w = pk2(bf_lo(u4.w) * t1[2], bf_hi(u4.w) * t1[3]);
        *(u32x4*)(Y + (size_t)(row0 + tk + 16 * i) * 1024 + 768 + c8 * 8) = y; }
}
__device__ __forceinline__ void phase_cm(const Frame& F, int l, bool with_ctx) {
    for (int u = F.vcu; u < 256; u += F.G) cm_unit(F, l, u * 128);
    if (with_ctx) for (int u = F.G - 33 - F.vcu; u >= 0 && u < 16; u += F.G) cm_unit(F, l, MX + u * 128);
    __syncthreads();
}

constexpr int CW_BARS = 131072;
#define DBG_SRC WS_Y
#define DBG_LD 96
#define DBG_C0 0
#define DBG_W 96
#ifndef STOP_AFTER
#define STOP_AFTER 22
#endif
constexpr int N_PHASES = STOP_AFTER + 1;
#ifndef MK_N_LAUNCHES
#define MK_N_LAUNCHES 1
#endif
struct Args { const float* in[29]; float* out; unsigned char* ws; int ph_lo, ph_hi, li, hm_tiles; };
static_assert(sizeof(Args) == 29 * 8 + 8 + 8 + 16, "Args has no padding");

template <int LAYER>
__device__ __forceinline__ void mixer_gemm1(const Frame& F) {
    SchedG1 S{(const char*)wsb(F, WS_N), (const char*)layer_w(F, LAYER, OFF_WIN), F.G, (int)blockIdx.x, LAYER};
    EpiG1 E{wsb(F, WS_CKV), wsb(F, WS_NAQ), wsb(F, WS_NAK), wsb(F, WS_U), wsb(F, WS_V), wsb(F, WS_CQ), wsb(F, WS_K), wsb(F, WS_NAVT), (float*)(F.ws + WS_SSQ), (const float*)(F.ws + WS_TAB)};
    pg8::gemm_phase<EpiG1, SchedG1, false>(F.lds, 2048, 2048, S, E, F.tid);
}
template <int LAYER>
__device__ __forceinline__ void mixer_gemm2(const Frame& F) {
    { SchedPlain S{(const char*)wsb(F, WS_CQ), (const char*)layer_w(F, LAYER, OFF_WUQ), 768, 768, 6, LAYER == 0 ? 136 : 128, 3, F.G, (int)blockIdx.x};
      EpiG2Q E{wsb(F, WS_Q), (const float*)(F.ws + WS_SSQ), (const float*)(F.ws + WS_TAB)};
      pg8::gemm_phase<EpiG2Q, SchedPlain, false>(F.lds, 768, 768, S, E, F.tid); }
    { SchedG2KV S{(const char*)wsb(F, WS_CKV), (const char*)layer_w(F, LAYER, OFF_WUKV), F.G, F.G - 1 - (int)blockIdx.x};
      EpiG2KV E{wsb(F, WS_K), wsb(F, WS_VT), (const float*)(F.ws + WS_SSQ)};
      pg8::gemm_phase<EpiG2KV, SchedG2KV, false>(F.lds, 512, 512, S, E, F.tid); }
}
template <int LAYER>
__device__ __forceinline__ void mixer_merge(const Frame& F) {
    SchedG3 S{(const char*)F.out, (const char*)wsb(F, WS_Y), (const char*)layer_w(F, LAYER, OFF_WGL), (const char*)layer_w(F, LAYER, OFF_WBR), LAYER == 0 ? 32 : 0, F.G, (int)blockIdx.x, 1};
    EpiG3 E{wsb(F, WS_Z), F.ws + WS_GSCR + (size_t)blockIdx.x * 262144, wsb(F, WS_ZP), 0.03125f};
    pg8::gemm_phase<EpiG3, SchedG3, false, false, true>(F.lds, 2048, 2048, S, E, F.tid);
}
struct SchedCtxSplit {
    const char* A; const char* B; const char* AP; int lda2, ldb2, nt, split, G, c;
    __device__ __forceinline__ bool next(int i, pg8::Unit& u) const {
        const int L = i * G + c;
        if (L < 512) { int pm, pn; static_tile(L, 128, 4, pm, pn); u.A = A + (size_t)pm * 256 * lda2; u.B = B + (size_t)pn * 256 * ldb2; u.nt = nt; u.job = 0; u.pm = pm; u.pn = pn; return true; }
        const int nx = (512 - c + G - 1) / G, p = c + (i - nx) * G; if (p >= 32 * split) return false;
        const int T = p / split, s = p - T * split, pmc = T >> 2, pn = T & 3; u.pm = 128 + pmc; u.pn = pn; u.job = 1 + s;
        if (split == 3) { u.A = AP + ((size_t)s * MC + pmc * 256) * lda2; u.B = B + (size_t)pn * 256 * ldb2; u.nt = nt; }
        else { const int h0 = ((nt / 2) + 1) & ~1;
            u.A = A + (size_t)(128 + pmc) * 256 * lda2 + (size_t)s * h0 * 128; u.B = B + (size_t)pn * 256 * ldb2 + (size_t)s * h0 * 128; u.nt = s ? nt - h0 : h0; }
        return true;
    }
};
struct EpiCtxSplit {
    bf16_t* O; bf16_t* P0; bf16_t* P1; float sc;
    __device__ __forceinline__ void operator()(const AccT& acc, const pg8::Unit& u, int wr, int wc, int fr, int fq) const {
        bf16_t* base = (u.job == 0) ? O + (size_t)u.pm * 256 * 1024 : ((u.job == 1) ? P0 : P1 + (size_t)(u.job - 2) * MC * 1024) + (size_t)(u.pm - 128) * 256 * 1024;
#pragma unroll
        for (int ai = 0; ai < 2; ++ai)
#pragma unroll
            for (int m = 0; m < 4; ++m) { bf16_t* rowp = base + (size_t)(ai * 128 + wr * 64 + m * 16 + fr) * 1024 + u.pn * 256 + wc * 32 + fq * 8;
#pragma unroll
                for (int bj = 0; bj < 2; ++bj) *(u32x4*)(rowp + bj * 128) = pack8(acc[ai][bj][m][0] * sc, acc[ai][bj][m][1] * sc); }
    }
};
template <int LAYER>
__device__ __forceinline__ void mixer_out(const Frame& F) {
    if (LAYER == 0) {
        SchedCtxSplit S{(const char*)wsb(F, WS_Z), (const char*)layer_w(F, LAYER, OFF_WOUT), (const char*)wsb(F, WS_ZP), 2048, 2048, 16, 3, F.G, (int)blockIdx.x};
        EpiCtxSplit E{wsb(F, WS_O), wsb(F, WS_OP), wsb(F, WS_OP) + (size_t)MC * 1024, 1.0f};
        pg8::gemm_phase<EpiCtxSplit, SchedCtxSplit, false>(F.lds, 2048, 2048, S, E, F.tid);
    } else {
        SchedPlain S{(const char*)wsb(F, WS_Z), (const char*)layer_w(F, LAYER, OFF_WOUT), 2048, 2048, 16, 128, 4, F.G, (int)blockIdx.x};
        EpiPlain E{wsb(F, WS_O), 1024};
        pg8::gemm_phase<EpiPlain, SchedPlain, false>(F.lds, 2048, 2048, S, E, F.tid);
    }
}

__global__ void __launch_bounds__(NTHR, 2) fwd(Args args) {
    extern __shared__ __attribute__((aligned(16))) unsigned char lds[];
    Frame F;
    F.lds = (LAS unsigned char*)lds; F.MISC = (volatile LAS unsigned*)(F.lds + LDS_MISC);
    F.tid = threadIdx.x; F.lane = F.tid & 63; F.wave = __builtin_amdgcn_readfirstlane(F.tid >> 6);
    F.G = gridDim.x; { const int bx = blockIdx.x; F.vcu = (F.G % 8 == 0) ? (bx % 8) * (F.G / 8) + bx / 8 : bx; }
    F.ws = args.ws; F.ctl = (unsigned*)(args.ws + WS_CTL); F.out = args.out; F.hm_tiles = args.hm_tiles;
    for (int u = F.tid; u < (LDS_BYTES - LDS_MISC) / 4; u += NTHR) ((LAS unsigned*)(F.lds + LDS_MISC))[u] = 0u;
    __syncthreads();
    if (F.tid == 0) {
#pragma unroll
        for (int i = 0; i < 29; ++i) { const unsigned long long p = (unsigned long long)args.in[i]; F.MISC[MI_IN + 2 * i] = (unsigned)p; F.MISC[MI_IN + 2 * i + 1] = (unsigned)(p >> 32); } }
    __syncthreads();
    const XcdBarrier bar = xcd_barrier_post(F.ctl + CW_BARS + args.li * 4096, F.MISC);
    const int lo = args.ph_lo, hi = args.ph_hi;
#ifndef ONLYP
#define ONLYP -1
#endif
#ifndef PROBE_DUP
#define PROBE_DUP 0
#endif
#define DUPN(k) for (int rep_ = 0; rep_ < ((PROBE_DUP == (k)) ? 2 : 1); ++rep_)
#define IN(k) ((ONLYP < 0 || ONLYP == (k)) && lo <= (k) && (k) < hi)
#define SEAM(k) do { if (IN((k) + 1)) xcd_barrier(bar, F.tid); } while (0)
#define REFRESH() do { int l_; asm volatile("v_mbcnt_lo_u32_b32 %0, -1, 0\n\tv_mbcnt_hi_u32_b32 %0, -1, %0" : "=v"(l_)); F.lane = l_; F.tid = F.wave * 64 + l_; } while (0)
    LAS float* tscr = (LAS float*)(F.lds + 32768 + F.wave * 8448);

    if (IN(0)) { REFRESH(); p0_convert_small(F, tscr); p0_mods(F); SEAM(0); }
    if (IN(1)) { REFRESH(); phase_T0(F); SEAM(1); }
    if (IN(2)) { DUPN(4) { REFRESH(); mixer_gemm1<0>(F); } SEAM(2); }
    if (IN(3)) { DUPN(4) { REFRESH(); mixer_gemm2<0>(F); } SEAM(3); }
    if (IN(4)) { DUPN(2) { REFRESH(); phase_mla(F, true); REFRESH(); phase_na(F, 0, true); REFRESH(); phase_cm(F, 0, true); } if (IN(7)) xcd_barrier(bar, F.tid); }
    if (IN(7)) { DUPN(1) { REFRESH(); mixer_merge<0>(F); } SEAM(7); }
    if (IN(8)) { DUPN(6) { REFRESH(); mixer_out<0>(F); } SEAM(8); }
    if (IN(9)) { REFRESH(); phase_T1<false>(F, 0); SEAM(9); }
    if (IN(10)) { DUPN(5) { REFRESH(); SchedPlain S{(const char*)wsb(F, WS_N), (const char*)wsb(F, WS_WF13), 1024, 1024, 8, 136, 22, F.G, (int)blockIdx.x}; EpiSwigluF8 E{F.ws + WS_HMID, DFF, 0};
        pg8::gemm_phase<EpiSwigluF8, SchedPlain, false, true>(F.lds, 1024, 1024, S, E, F.tid); } SEAM(10); }
    if (IN(11)) { DUPN(5) { REFRESH(); SchedCtxSplit S{(const char*)wsb(F, WS_HMID), (const char*)wsb(F, WS_WF2), nullptr, DFF, DFF, DFF / 128, 2, F.G, (int)blockIdx.x};
        EpiCtxSplit E{wsb(F, WS_F), wsb(F, WS_F) + (size_t)MX * 1024, wsb(F, WS_FP), 0.015625f};
        pg8::gemm_phase<EpiCtxSplit, SchedCtxSplit, false, true>(F.lds, DFF, DFF, S, E, F.tid); } SEAM(11); }
    if (IN(12)) { REFRESH(); phase_T2<false, false>(F, 0); SEAM(12); }
    if (IN(13)) { DUPN(4) { REFRESH(); mixer_gemm1<1>(F); } SEAM(13); }
    if (IN(14)) { DUPN(4) { REFRESH(); mixer_gemm2<1>(F); } SEAM(14); }
    if (IN(15)) { DUPN(2) { REFRESH(); phase_mla(F, false); REFRESH(); phase_na(F, 1, false); REFRESH(); phase_cm(F, 1, false); } if (IN(18)) xcd_barrier(bar, F.tid); }
    if (IN(18)) { DUPN(1) { REFRESH(); mixer_merge<1>(F); } SEAM(18); }
    if (IN(19)) { DUPN(6) { REFRESH(); mixer_out<1>(F); } SEAM(19); }
    if (IN(20)) { REFRESH(); p0_convert_moe(F, tscr); phase_T1<true>(F, 1); SEAM(20); }
    if (IN(21)) { REFRESH();
        __syncthreads();
        if (F.tid == 0) { unsigned tb = 0;
            for (int e = 0; e < 8; ++e) { const unsigned c = __hip_atomic_load(F.ctl + CW_CNT + 64 * e, __ATOMIC_RELAXED, __HIP_MEMORY_SCOPE_AGENT); F.MISC[MI_CNT + e] = c; F.MISC[MI_TB + e] = tb; tb += (c + 255u) >> 8; }
            F.MISC[MI_TB + 8] = tb; }
        __syncthreads();
        const int T_tot = __builtin_amdgcn_readfirstlane((int)F.MISC[MI_TB + 8]);
        {
            const unsigned char* N8 = F.ws + WS_N8M; unsigned char* XG = (unsigned char*)F.out;        const int* LT = (const int*)(F.ws + WS_LTOK);
            int tbv[9], cntv[8];
#pragma unroll
            for (int j = 0; j < 9; ++j) tbv[j] = __builtin_amdgcn_readfirstlane((int)F.MISC[MI_TB + j]);
#pragma unroll
            for (int j = 0; j < 8; ++j) cntv[j] = __builtin_amdgcn_readfirstlane((int)F.MISC[MI_CNT + j]);
            const int R0 = F.vcu * NWAVES + F.wave, RS = F.G * NWAVES, NR = T_tot * 256;
            for (int Rb = R0; Rb < NR; Rb += 4 * RS) {
                int tok[4];
#pragma unroll
                for (int k = 0; k < 4; ++k) { const int R = Rb + k * RS; tok[k] = 0;
                    if (R < NR) { const int gt = R >> 8; int e = 0, tbe = 0, ce = cntv[0];
#pragma unroll
                        for (int j = 1; j < 8; ++j) if (tbv[j] <= gt) { e = j; tbe = tbv[j]; ce = cntv[j]; }
                        const int pos = (gt - tbe) * 256 + (R & 255); if (pos < ce) tok[k] = LT[e * 32768 + pos] >> 1; } }
                u32x4 row[4];
#pragma unroll
                for (int k = 0; k < 4; ++k) row[k] = *(const u32x4*)(N8 + (size_t)tok[k] * 1024 + F.lane * 16);
#pragma unroll
                for (int k = 0; k < 4; ++k) { const int R = Rb + k * RS; if (R < NR) *(u32x4*)(XG + (size_t)R * 1024 + F.lane * 16) = row[k]; } }
            xcd_barrier(bar, F.tid);
        }
#define TBR(j_) __builtin_amdgcn_readfirstlane((int)F.MISC[MI_TB + (j_)])
        if (F.G == 256 && F.hm_tiles >= T_tot && T_tot >= 256 && T_tot <= 264) {
            const int tA = T_tot - 128, nx = 4 * (tA - 128);
            { SchedMoeUp S{(const char*)F.out, (const char*)(F.ws + WS_WM13), F.MISC, 0, tA, F.G, (int)blockIdx.x, {TBR(1), TBR(2), TBR(3), TBR(4), TBR(5), TBR(6), TBR(7)}, 0}; EpiSwigluF8 E{F.ws + WS_HM, DFE, 0};
              pg8::gemm_phase<EpiSwigluF8, SchedMoeUp, false, true>(F.lds, 1024, 1024, S, E, F.tid); }
            xcd_barrier(bar, F.tid);
            { SchedMoeDown S{(const char*)wsb(F, WS_HM), (const char*)wsb(F, WS_WM2), F.MISC, 0, tA, F.G, (int)blockIdx.x, {TBR(1), TBR(2), TBR(3), TBR(4), TBR(5), TBR(6), TBR(7)}};
              EpiMoeDown E{wsb(F, WS_Y2), (const int*)(F.ws + WS_LTOK), (const float*)(F.ws + WS_LW), F.MISC};
              pg8::gemm_phase<EpiMoeDown, SchedMoeDown, false, true>(F.lds, DFE, DFE, S, E, F.tid); }
            { SchedMoeUp S{(const char*)F.out, (const char*)(F.ws + WS_WM13), F.MISC, tA, T_tot, F.G, (int)blockIdx.x, {TBR(1), TBR(2), TBR(3), TBR(4), TBR(5), TBR(6), TBR(7)}, nx}; EpiSwigluF8 E{F.ws + WS_HM, DFE, 0};
              pg8::gemm_phase<EpiSwigluF8, SchedMoeUp, false, true>(F.lds, 1024, 1024, S, E, F.tid); }
            xcd_barrier(bar, F.tid);
            { SchedMoeDown S{(const char*)(F.ws + WS_HM + (size_t)tA * 256 * DFE), (const char*)wsb(F, WS_WM2), F.MISC, tA, T_tot, F.G, (int)blockIdx.x, {TBR(1), TBR(2), TBR(3), TBR(4), TBR(5), TBR(6), TBR(7)}};
              EpiMoeDown E{wsb(F, WS_Y2), (const int*)(F.ws + WS_LTOK), (const float*)(F.ws + WS_LW), F.MISC};
              pg8::gemm_phase<EpiMoeDown, SchedMoeDown, false, true>(F.lds, DFE, DFE, S, E, F.tid); }
            xcd_barrier(bar, F.tid);
        } else
        for (int t_lo = 0; t_lo < T_tot; t_lo += F.hm_tiles) { const int t_hi = (t_lo + F.hm_tiles < T_tot) ? t_lo + F.hm_tiles : T_tot;
            DUPN(3) { SchedMoeUp S{(const char*)F.out, (const char*)(F.ws + WS_WM13), F.MISC, t_lo, t_hi, F.G, (int)blockIdx.x, {TBR(1), TBR(2), TBR(3), TBR(4), TBR(5), TBR(6), TBR(7)}}; EpiSwigluF8 E{F.ws + WS_HM, DFE, t_lo};
              pg8::gemm_phase<EpiSwigluF8, SchedMoeUp, false, true>(F.lds, 1024, 1024, S, E, F.tid); }
            xcd_barrier(bar, F.tid);
            DUPN(8) { SchedMoeDown S{(const char*)wsb(F, WS_HM), (const char*)wsb(F, WS_WM2), F.MISC, t_lo, t_hi, F.G, (int)blockIdx.x, {TBR(1), TBR(2), TBR(3), TBR(4), TBR(5), TBR(6), TBR(7)}};
              EpiMoeDown E{wsb(F, WS_Y2), (const int*)(F.ws + WS_LTOK), (const float*)(F.ws + WS_LW), F.MISC};
              pg8::gemm_phase<EpiMoeDown, SchedMoeDown, false, true>(F.lds, DFE, DFE, S, E, F.tid); }
            xcd_barrier(bar, F.tid);
        }
    }
    if (IN(22)) { REFRESH(); phase_T2<true, true>(F, 1); }
#ifdef DBG_DUMP_HC
    if (lo == 100) { const bf16_t* SRC = wsb(F, DBG_SRC); const int gw = F.vcu * NWAVES + F.wave;
        for (int r = gw; r < MX; r += F.G * NWAVES) for (int c = F.lane; c < 1024; c += 64) F.out[(size_t)r * 1024 + c] = bf_lo((unsigned)SRC[(size_t)r * 1024 + (c % 512)]); }
#endif
#undef IN
#undef SEAM
}

extern "C" void kernel_launch(void* const* d_in, const int* in_sizes, int n_in, void* d_out, int out_size, void* d_ws, size_t ws_size, hipStream_t stream) {
    static int grid = 0; static int hm_tiles = 0;
    if (grid == 0) {
        if (n_in != 29 || out_size != MX * DM) { fprintf(stderr, "kernel_launch: unexpected problem shape (n_in %d, out %d)\n", n_in, out_size); grid = -1; return; }
        const size_t avail = ws_size > WS_HM ? (ws_size - WS_HM) / HM_TILE_BYTES : 0;
        if (ws_size < WS_END || avail < 8) { fprintf(stderr, "kernel_launch: workspace too small: %zu bytes (need %zu for the mixer, %zu + 8 tiles for the experts)\n", ws_size, (size_t)WS_MIX_END, (size_t)WS_HM); grid = -1; return; }
        const int maxt = avail > 264 ? 264 : (int)avail; const int npass = (264 + maxt - 1) / maxt; hm_tiles = (264 + npass - 1) / npass;
        int dev = 0, cus = 0;
        if (hipGetDevice(&dev) != hipSuccess || hipDeviceGetAttribute(&cus, hipDeviceAttributeMultiprocessorCount, dev) != hipSuccess) { grid = -1; return; }
        if (hipFuncSetAttribute((const void*)fwd, hipFuncAttributeMaxDynamicSharedMemorySize, LDS_BYTES) != hipSuccess) { fprintf(stderr, "kernel_launch: hipFuncSetAttribute failed\n"); grid = -1; return; }
        int per_cu = 0;
        if (hipOccupancyMaxActiveBlocksPerMultiprocessor(&per_cu, (const void*)fwd, NTHR, LDS_BYTES) != hipSuccess || per_cu < 1) fprintf(stderr, "kernel_launch: occupancy query reports %d\n", per_cu);
        (void)hipGetLastError();
        grid = cus > 256 ? 256 : cus;
        fprintf(stderr, "kernel_launch: grid %d, hm_tiles %d, ws %zu MiB (mixer end %zu MiB, HM at %zu MiB)\n", grid, hm_tiles, ws_size >> 20, (size_t)(WS_MIX_END >> 20), (size_t)(WS_HM >> 20));
    }
    if (grid < 0) return;
    if (hipMemsetAsync((char*)d_ws + WS_CTL, 0, CTL_ZERO_BYTES, stream) != hipSuccess) return;
    Args a{};
    for (int i = 0; i < 29; ++i) a.in[i] = (const float*)d_in[i];
    a.out = (float*)d_out; a.ws = (unsigned char*)d_ws; a.hm_tiles = hm_tiles;
    if (MK_N_LAUNCHES == 1) { a.ph_lo = 0; a.ph_hi = N_PHASES; a.li = 0; hipLaunchKernelGGL(fwd, dim3(grid), dim3(NTHR), LDS_BYTES, stream, a); }
    else for (int li = 0; li < N_PHASES; ++li) { a.ph_lo = li; a.ph_hi = li + 1; a.li = li; hipLaunchKernelGGL(fwd, dim3(grid), dim3(NTHR), LDS_BYTES, stream, a); }
#ifdef DBG_DUMP_HC
    a.ph_lo = 100; a.ph_hi = 101; a.li = 23; hipLaunchKernelGGL(fwd, dim3(grid), dim3(NTHR), LDS_BYTES, stream, a);
#endif
}
```
